# Optimizing an MI355X kernel written in HIP

```python
import math
import jax, jax.numpy as jnp
from jax import lax
import numpy as np

D_MODEL = 1024
BATCH = 8
SEQ = 8192
DEPTH = 4
DEC_BATCH = 2
DEC_SEQ = 16384
PAST_LEN = 128

HG_HEADS = 4
HG_DK = 128
HG_DV = 128
HG_WIDTH = HG_HEADS * HG_DV
HG_CHUNK = 64
AT_HEADS = 4
AT_HEAD_DIM = 64
AT_WIDTH = AT_HEADS * AT_HEAD_DIM
DIL_PATTERNS = ((128, 1), (512, 4), (2048, 16))
DIL_BLOCK = 64
ROPE_THETA = 500000.0
ROPE_DIM = AT_HEAD_DIM // 4
MEM_TOKENS = 256
MEM_HEADS = 4
MEM_HEAD_DIM = 64
MEM_WIDTH = MEM_HEADS * MEM_HEAD_DIM
MIX_WIDTH = HG_WIDTH + AT_WIDTH + MEM_WIDTH
NORM_EPS = 1e-6
MASK_VALUE = -1e30
SPLITS = (HG_WIDTH, HG_WIDTH, HG_WIDTH, HG_WIDTH, AT_WIDTH, AT_WIDTH, AT_WIDTH, MEM_WIDTH, HG_WIDTH, AT_WIDTH, MEM_WIDTH)
IN_WIDTH = 4 * HG_WIDTH + 3 * AT_WIDTH + MEM_WIDTH + MIX_WIDTH

kernel_name = 'hybrid_hgrn2_dilated_memory_encoder'


def _rms_norm(x, w):
    xf = x.astype(jnp.float32)
    y = xf * lax.rsqrt(jnp.mean(xf * xf, axis=-1, keepdims=True) + NORM_EPS)
    return (y * w.astype(jnp.float32)).astype(x.dtype)


def _head_norm(t, w):
    return t * lax.rsqrt(jnp.mean(t * t, axis=-1, keepdims=True) + NORM_EPS) * w.astype(jnp.float32)


def _partial_rope(t, pos):
    half = ROPE_DIM // 2
    inv_freq = ROPE_THETA ** (-jnp.arange(half, dtype=jnp.float32) * 2.0 / ROPE_DIM)
    ang = pos[:, None] * inv_freq[None, :]
    cos = jnp.cos(ang)[None, :, None, :]
    sin = jnp.sin(ang)[None, :, None, :]
    t1 = t[..., :half]
    t2 = t[..., half:ROPE_DIM]
    return jnp.concatenate([t1 * cos - t2 * sin, t2 * cos + t1 * sin, t[..., ROPE_DIM:]], axis=-1)


def _layer_lower_bounds(p):
    sm = jax.nn.softmax(p.astype(jnp.float32), axis=0)
    return jnp.cumsum(sm, axis=0) - sm[0:1]


def _hgrn2_chunk_scan(q, k, log_f, v):
    B, H, S, dk = q.shape
    dv = v.shape[-1]
    nc = S // HG_CHUNK

    def to_chunks(t):
        return t.reshape(B, H, nc, HG_CHUNK, t.shape[-1]).transpose(2, 0, 1, 3, 4)

    causal = jnp.tril(jnp.ones((HG_CHUNK, HG_CHUNK), dtype=bool))[None, None, :, :, None]

    def step(state, inp):
        qc, kc, lfc, vc = inp
        b = jnp.cumsum(lfc, axis=-2)
        b_last = b[:, :, -1:, :]
        o_inter = jnp.einsum('bhtk,bhkv->bhtv', qc * jnp.exp(b), state)
        diff = b[:, :, :, None, :] - b[:, :, None, :, :]
        decay = jnp.where(causal, jnp.exp(jnp.where(causal, diff, 0.0)), 0.0)
        scores = jnp.einsum('bhtk,bhsk,bhtsk->bhts', qc, kc, decay)
        o_intra = jnp.einsum('bhts,bhsv->bhtv', scores, vc)
        new_state = (jnp.exp(b_last[:, :, 0, :])[..., None] * state
                     + jnp.einsum('bhsk,bhsv->bhkv', kc * jnp.exp(b_last - b), vc))
        return new_state, o_inter + o_intra

    state0 = jnp.zeros((B, H, dk, dv), jnp.float32)
    _, o = lax.scan(step, state0, (to_chunks(q), to_chunks(k), to_chunks(log_f), to_chunks(v)))
    return o.transpose(1, 2, 0, 3, 4).reshape(B, H, S, dv)


def _dilated_branch(q, k, v, window, dilation):
    B, S, H, Dh = q.shape
    half = window // (2 * dilation)
    L = S // dilation
    nb = -(-L // DIL_BLOCK)
    Lp = nb * DIL_BLOCK

    def to_sub(t):
        return t.reshape(B, L, dilation, H, Dh).transpose(0, 2, 3, 1, 4)

    qs = jnp.pad(to_sub(q), ((0, 0), (0, 0), (0, 0), (0, Lp - L), (0, 0))).reshape(B, dilation, H, nb, DIL_BLOCK, Dh)

    def neighbour_blocks(t):
        tp = jnp.pad(to_sub(t), ((0, 0), (0, 0), (0, 0), (DIL_BLOCK, DIL_BLOCK + Lp - L), (0, 0)))
        tp = tp.reshape(B, dilation, H, nb + 2, DIL_BLOCK, Dh)
        return jnp.concatenate([tp[:, :, :, :-2], tp[:, :, :, 1:-1], tp[:, :, :, 2:]], axis=-2)

    kb = neighbour_blocks(k)
    vb = neighbour_blocks(v)
    qi = (jnp.arange(nb)[:, None] * DIL_BLOCK + jnp.arange(DIL_BLOCK)[None, :])[:, :, None]
    kj = (jnp.arange(nb)[:, None] * DIL_BLOCK - DIL_BLOCK + jnp.arange(3 * DIL_BLOCK)[None, :])[:, None, :]
    valid = (jnp.abs(kj - qi) <= half) & (kj >= 0) & (kj < L)
    s = jnp.einsum('brhnqd,brhnkd->brhnqk', qs, kb) * (Dh ** -0.5)
    s = jnp.where(valid, s, MASK_VALUE)
    lse = jax.nn.logsumexp(s, axis=-1)
    p = jnp.exp(s - lse[..., None])
    o = jnp.einsum('brhnqk,brhnkd->brhnqd', p, vb)

    def from_sub(t):
        t = t.reshape((B, dilation, H, Lp) + t.shape[5:])[:, :, :, :L]
        t = jnp.moveaxis(t, 3, 1)
        return t.reshape((B, S, H) + t.shape[4:])

    return from_sub(o), from_sub(lse)


def _layer(x, mem, pos, lb_f, lb_b, norm_w, w_in, hg_onorm_w, aq_w, ak_w, mem_norm_w, mem_wkv, mq_w, mk_w, w_out):
    B, S, _ = x.shape
    f32 = jnp.float32
    h = _rms_norm(x, norm_w)
    z = jnp.matmul(h, w_in).astype(f32)
    points = [int(p) for p in np.cumsum(SPLITS)[:-1]]
    hq, hf_fwd, hf_bwd, hi, aq, ak, av, mq, g_hg, g_at, g_mem = jnp.split(z, points, axis=-1)

    def hg_heads(t, d):
        return t.reshape(B, S, HG_HEADS, d).transpose(0, 2, 1, 3)

    q = jax.nn.silu(hg_heads(hq, HG_DK))
    v = hg_heads(hi, HG_DV)

    def gate_terms(zf, lb):
        lb = lb.astype(f32).reshape(1, HG_HEADS, 1, HG_DK)
        f = lb + (1.0 - lb) * jax.nn.sigmoid(zf)
        log_f = jnp.log(f)
        kk = (1.0 - lb) * jax.nn.sigmoid(-zf)
        return log_f, kk

    logf_f, k_f = gate_terms(hg_heads(hf_fwd, HG_DK), lb_f)
    logf_b, k_b = gate_terms(hg_heads(hf_bwd, HG_DK), lb_b)
    o_fwd = _hgrn2_chunk_scan(q, k_f, logf_f, v)
    flip = lambda t: jnp.flip(t, axis=2)
    o_bwd = flip(_hgrn2_chunk_scan(flip(q), flip(k_b), flip(logf_b), flip(v)))
    o_hg = _head_norm((o_fwd + o_bwd).transpose(0, 2, 1, 3), hg_onorm_w).reshape(B, S, HG_WIDTH)
    o_hg = o_hg * jax.nn.silu(g_hg)

    qa = _partial_rope(_head_norm(aq.reshape(B, S, AT_HEADS, AT_HEAD_DIM), aq_w), pos)
    ka = _partial_rope(_head_norm(ak.reshape(B, S, AT_HEADS, AT_HEAD_DIM), ak_w), pos)
    va = av.reshape(B, S, AT_HEADS, AT_HEAD_DIM)
    outs = []
    lses = []
    for window, dilation in DIL_PATTERNS:
        o_i, lse_i = _dilated_branch(qa, ka, va, window, dilation)
        outs.append(o_i)
        lses.append(lse_i)
    wts = jax.nn.softmax(jnp.stack(lses, axis=0), axis=0)
    o_at = jnp.sum(wts[..., None] * jnp.stack(outs, axis=0), axis=0).reshape(B, S, AT_WIDTH)
    o_at = o_at * jax.nn.silu(g_at)

    M = mem.shape[1]
    mh = _rms_norm(mem, mem_norm_w)
    mkv = jnp.matmul(mh, mem_wkv).astype(f32)
    mk = _head_norm(mkv[..., :MEM_WIDTH].reshape(B, M, MEM_HEADS, MEM_HEAD_DIM), mk_w)
    mv = mkv[..., MEM_WIDTH:].reshape(B, M, MEM_HEADS, MEM_HEAD_DIM)
    mqh = _head_norm(mq.reshape(B, S, MEM_HEADS, MEM_HEAD_DIM), mq_w)
    sm = jnp.einsum('bshd,bmhd->bhsm', mqh, mk) * (MEM_HEAD_DIM ** -0.5)
    pm = jax.nn.softmax(sm, axis=-1)
    o_mem = jnp.einsum('bhsm,bmhd->bshd', pm, mv).reshape(B, S, MEM_WIDTH)
    o_mem = o_mem * jax.nn.silu(g_mem)

    mixed = jnp.concatenate([o_hg, o_at, o_mem], axis=-1).astype(x.dtype)
    return x + jnp.matmul(mixed, w_out)


def setup_inputs(seed: int = 0) -> dict:
    key = jax.random.key(seed)
    ks = jax.random.split(key, 16)
    f32 = jnp.float32
    nrm = lambda k, shape, scale: scale * jax.random.normal(k, shape, f32)
    return {
        'x_prompt': nrm(ks[0], (BATCH, SEQ, D_MODEL), 1.0),
        'x_sample': nrm(ks[1], (DEC_BATCH, DEC_SEQ, D_MODEL), 1.0),
        'mem_prompt': nrm(ks[2], (BATCH, MEM_TOKENS, D_MODEL), 1.0),
        'mem_sample': nrm(ks[3], (DEC_BATCH, MEM_TOKENS, D_MODEL), 1.0),
        'norm_w': 1.0 + nrm(ks[4], (DEPTH, D_MODEL), 0.02),
        'w_in': nrm(ks[5], (DEPTH, D_MODEL, IN_WIDTH), D_MODEL ** -0.5),
        'hgrn_lb_fwd': nrm(ks[6], (DEPTH, HG_WIDTH), 0.1),
        'hgrn_lb_bwd': nrm(ks[7], (DEPTH, HG_WIDTH), 0.1),
        'hgrn_onorm_w': 1.0 + nrm(ks[8], (DEPTH, HG_DV), 0.02),
        'attn_qnorm_w': 1.0 + nrm(ks[9], (DEPTH, AT_HEAD_DIM), 0.02),
        'attn_knorm_w': 1.0 + nrm(ks[10], (DEPTH, AT_HEAD_DIM), 0.02),
        'mem_norm_w': 1.0 + nrm(ks[11], (DEPTH, D_MODEL), 0.02),
        'mem_wkv': nrm(ks[12], (DEPTH, D_MODEL, 2 * MEM_WIDTH), D_MODEL ** -0.5),
        'mem_qnorm_w': 1.0 + nrm(ks[13], (DEPTH, MEM_HEAD_DIM), 0.02),
        'mem_knorm_w': 1.0 + nrm(ks[14], (DEPTH, MEM_HEAD_DIM), 0.02),
        'w_out': nrm(ks[15], (DEPTH, MIX_WIDTH, D_MODEL), MIX_WIDTH ** -0.5),
    }


def reference(x_prompt, x_sample, mem_prompt, mem_sample, norm_w, w_in, hgrn_lb_fwd, hgrn_lb_bwd, hgrn_onorm_w, attn_qnorm_w, attn_knorm_w, mem_norm_w, mem_wkv, mem_qnorm_w, mem_knorm_w, w_out):
    lb_fwd = _layer_lower_bounds(hgrn_lb_fwd)
    lb_bwd = _layer_lower_bounds(hgrn_lb_bwd)

    def trunk(x, mem):
        pos = jnp.arange(x.shape[1], dtype=jnp.float32)
        for l in range(DEPTH):
            x = _layer(x, mem, pos, lb_fwd[l], lb_bwd[l], norm_w[l], w_in[l], hgrn_onorm_w[l],
                       attn_qnorm_w[l], attn_knorm_w[l], mem_norm_w[l], mem_wkv[l],
                       mem_qnorm_w[l], mem_knorm_w[l], w_out[l])
        return x

    y_prompt = trunk(x_prompt, mem_prompt)
    y_sample = trunk(x_sample, mem_sample)
    return (y_prompt, y_sample)
```

```cpp
#include <hip/hip_runtime.h>
#include <hip/hip_cooperative_groups.h>
#include <cstdio>
#include <cstdint>
namespace cg = cooperative_groups;

#define DI __device__ __forceinline__
typedef unsigned short bf16_t;
typedef short bf16x8 __attribute__((ext_vector_type(8)));
typedef short s16x4 __attribute__((ext_vector_type(4)));
typedef float f32x4 __attribute__((ext_vector_type(4)));
typedef float f32x16 __attribute__((ext_vector_type(16)));
typedef float f2v __attribute__((ext_vector_type(2)));
typedef __bf16 bf2v __attribute__((ext_vector_type(2)));
typedef unsigned u32x4 __attribute__((ext_vector_type(4)));
typedef unsigned u32x2 __attribute__((ext_vector_type(2)));
#define LDSAS __attribute__((address_space(3)))

#ifndef REP_INPROJ
#define REP_INPROJ 1
#endif
#ifndef REP_S1
#define REP_S1 1
#endif
constexpr int T_TOK = 98304;
constexpr int T_PROMPT = 65536;
constexpr int NIN = 4096;
constexpr float EPS = 1e-6f;

constexpr size_t OFF_Z = 0;
constexpr size_t SZ_Z = (size_t)T_TOK * NIN * 2;
constexpr size_t OFF_XB = OFF_Z + SZ_Z;
constexpr size_t SZ_XB = (size_t)T_TOK * 1024 * 2;
constexpr size_t OFF_H = OFF_XB;
constexpr size_t SZ_H = (size_t)1536 * 16384 * 4;
constexpr size_t OFF_DS = OFF_H + SZ_H;
constexpr size_t OFF_WIN = OFF_XB + SZ_XB;
constexpr size_t SZ_WIN = (size_t)4 * 4096 * 1024 * 2;
constexpr size_t OFF_WOUT = OFF_WIN + SZ_WIN;
constexpr size_t SZ_WOUT = (size_t)4 * 1024 * 1024 * 2;
constexpr size_t OFF_WKV = OFF_WOUT + SZ_WOUT;
constexpr size_t SZ_WKV = (size_t)4 * 512 * 1024 * 2;
constexpr size_t OFF_MEMB = OFF_WKV + SZ_WKV;
constexpr size_t SZ_MEMB = (size_t)2560 * 1024 * 2;
constexpr size_t OFF_MKV = OFF_MEMB + SZ_MEMB;
constexpr size_t SZ_MKV = (size_t)4 * 2560 * 512 * 2;
constexpr size_t OFF_XSS = OFF_MKV + SZ_MKV;
constexpr size_t SZ_XSS = (size_t)T_TOK * 4;
constexpr size_t OFF_MEMSS = OFF_XSS + SZ_XSS;
constexpr size_t SZ_MEMSS = 2560 * 4;
constexpr size_t OFF_LB = OFF_MEMSS + SZ_MEMSS;
constexpr size_t SZ_LB = 2 * 4 * 512 * 4;
constexpr size_t OFF_BAR = OFF_LB + SZ_LB;
constexpr size_t SZ_BAR = 3456 * 4;
constexpr size_t WS_NEED = OFF_BAR + SZ_BAR;

constexpr int C_HQ = 0, C_FF = 512, C_FB = 1024, C_HI = 1536, C_AQ = 2048, C_AK = 2304, C_AV = 2560, C_MQ = 2816,
              C_GH = 3072, C_GA = 3584, C_GM = 3840;

struct Params {
  const float* x_prompt; const float* x_sample; const float* mem_prompt; const float* mem_sample;
  const float* norm_w; const float* w_in; const float* lb_fwd; const float* lb_bwd; const float* hg_onorm_w;
  const float* aq_w; const float* ak_w; const float* mem_norm_w; const float* mem_wkv; const float* mq_w; const float* mk_w;
  const float* w_out;
  float* out; unsigned char* ws;
};

DI unsigned pk2(float a, float b) { f2v v = {a, b}; bf2v r = __builtin_convertvector(v, bf2v); return __builtin_bit_cast(unsigned, r); }
DI float bflo(unsigned u) { return __uint_as_float(u << 16); }
DI float bfhi(unsigned u) { return __uint_as_float(u & 0xffff0000u); }
DI float bf2f(bf16_t v) { return __uint_as_float(((unsigned)v) << 16); }
DI bf16_t f2bf(float a) { return (bf16_t)(pk2(a, 0.f) & 0xffffu); }
DI float fexp(float x) { return __expf(x); }
DI float frcp(float x) { return __builtin_amdgcn_rcpf(x); }
DI float silu(float x) { return x * frcp(1.f + fexp(-x)); }
DI f32x4 mfma16(bf16x8 a, bf16x8 b, f32x4 c) { return __builtin_amdgcn_mfma_f32_16x16x32_bf16(a, b, c, 0, 0, 0); }
DI f32x16 mfma32(bf16x8 a, bf16x8 b, f32x16 c) { return __builtin_amdgcn_mfma_f32_32x32x16_bf16(a, b, c, 0, 0, 0); }
DI s16x4 trread(const unsigned char* p) { return __builtin_amdgcn_ds_read_tr16_b64_v4i16((LDSAS s16x4*)p); }
DI bf16x8 cat4(s16x4 lo, s16x4 hi) { return __builtin_shufflevector(lo, hi, 0, 1, 2, 3, 4, 5, 6, 7); }
DI int crow(int reg, int h) { return (reg & 3) + 8 * (reg >> 2) + 4 * h; }
DI void tok_info(int t, int& seq_start, int& S) {
  if (t < T_PROMPT) { seq_start = t & ~8191; S = 8192; } else { seq_start = T_PROMPT + ((t - T_PROMPT) & ~16383); S = 16384; }
}
#define CBAR() asm volatile("" ::: "memory")

DI void prep_row(const float* __restrict__ src, bf16_t* __restrict__ dst, float* __restrict__ ss, int lane) {
  const float4* s4 = (const float4*)src;
  float acc = 0.f;
#pragma unroll
  for (int i = 0; i < 4; ++i) {
    const f32x4 v4 = __builtin_nontemporal_load((const f32x4*)s4 + lane + 64 * i);
    float4 v = make_float4(v4[0], v4[1], v4[2], v4[3]);
    acc += v.x * v.x + v.y * v.y + v.z * v.z + v.w * v.w;
    u32x2 o = {pk2(v.x, v.y), pk2(v.z, v.w)};
    *(u32x2*)(dst + (lane + 64 * i) * 4) = o;
  }
#pragma unroll
  for (int s = 32; s >= 1; s >>= 1) acc += __shfl_xor(acc, s);
  if (lane == 0) *ss = acc;
}

DI void transpose_tile(const float* __restrict__ src, int N, const float* __restrict__ scale, bf16_t* __restrict__ dst,
                       int k0, int n0, unsigned char* ldsb, int tid) {
  bf16_t* lds = (bf16_t*)ldsb;
  __syncthreads();
#pragma unroll 4
  for (int j = 0; j < 16; ++j) {
    int k = (tid >> 6) + 4 * j;
    float v = __builtin_nontemporal_load(src + (size_t)(k0 + k) * N + n0 + (tid & 63));
    if (scale) v *= scale[k0 + k];
    lds[(tid & 63) * 66 + k] = f2bf(v);
  }
  __syncthreads();
#pragma unroll
  for (int j = 0; j < 8; ++j) {
    int n = (tid >> 5) + 8 * j;
    unsigned v = *(const unsigned*)&lds[n * 66 + (tid & 31) * 2];
    *(unsigned*)&dst[(size_t)(n0 + n) * 1024 + k0 + (tid & 31) * 2] = v;
  }
}

DI void phase_prep(const Params& p, unsigned char* lds, int vb, int vg, int tid) {
  unsigned char* ws = p.ws;
  bf16_t* XB = (bf16_t*)(ws + OFF_XB);
  float* XSS = (float*)(ws + OFF_XSS);
  bf16_t* MEMB = (bf16_t*)(ws + OFF_MEMB);
  float* MEMSS = (float*)(ws + OFF_MEMSS);
  bf16_t* WIN = (bf16_t*)(ws + OFF_WIN);
  bf16_t* WOUT = (bf16_t*)(ws + OFF_WOUT);
  bf16_t* WKV = (bf16_t*)(ws + OFF_WKV);
  float* LB = (float*)(ws + OFF_LB);
  const int lane = tid & 63, wid = tid >> 6;
  constexpr int N_ROWIT = (T_TOK + 2560) / 4;
  constexpr int N_TR_IN = 4 * 16 * 64, N_TR_OUT = 4 * 16 * 16, N_TR_KV = 4 * 16 * 8;
  constexpr int N_ITEMS = N_ROWIT + N_TR_IN + N_TR_OUT + N_TR_KV;
  for (int it = vb; it < N_ITEMS; it += vg) {
    if (it < N_ROWIT) {
      int row = it * 4 + wid;
      if (row < T_TOK) {
        const float* src = row < T_PROMPT ? p.x_prompt + (size_t)row * 1024 : p.x_sample + (size_t)(row - T_PROMPT) * 1024;
        prep_row(src, XB + (size_t)row * 1024, XSS + row, lane);
      } else {
        int r = row - T_TOK;
        const float* src = r < 2048 ? p.mem_prompt + (size_t)r * 1024 : p.mem_sample + (size_t)(r - 2048) * 1024;
        prep_row(src, MEMB + (size_t)r * 1024, MEMSS + r, lane);
      }
    } else if (it < N_ROWIT + N_TR_IN) {
      int i = it - N_ROWIT; int l = i >> 10, kt = (i >> 6) & 15, nt = i & 63;
      transpose_tile(p.w_in + (size_t)l * 1024 * 4096, 4096, p.norm_w + l * 1024, WIN + (size_t)l * 4096 * 1024, kt * 64, nt * 64, lds, tid);
    } else if (it < N_ROWIT + N_TR_IN + N_TR_OUT) {
      int i = it - N_ROWIT - N_TR_IN; int l = i >> 8, kt = (i >> 4) & 15, nt = i & 15;
      transpose_tile(p.w_out + (size_t)l * 1024 * 1024, 1024, nullptr, WOUT + (size_t)l * 1024 * 1024, kt * 64, nt * 64, lds, tid);
    } else {
      int i = it - N_ROWIT - N_TR_IN - N_TR_OUT; int l = i >> 7, kt = (i >> 3) & 15, nt = i & 7;
      transpose_tile(p.mem_wkv + (size_t)l * 1024 * 512, 512, p.mem_norm_w + l * 1024, WKV + (size_t)l * 512 * 1024, kt * 64, nt * 64, lds, tid);
    }
  }
  if (vb == 0) {
    for (int idx = tid; idx < 1024; idx += 256) {
      int dir = idx >> 9, c = idx & 511;
      const float* src = dir ? p.lb_bwd : p.lb_fwd;
      float v0 = src[c], v1 = src[512 + c], v2 = src[1024 + c], v3 = src[1536 + c];
      float m = fmaxf(fmaxf(v0, v1), fmaxf(v2, v3));
      float e0 = expf(v0 - m), e1 = expf(v1 - m), e2 = expf(v2 - m), e3 = expf(v3 - m);
      float inv = 1.f / (e0 + e1 + e2 + e3);
      float* o = LB + dir * 2048 + c;
      o[0] = 0.f; o[512] = e1 * inv; o[1024] = (e1 + e2) * inv; o[1536] = (e1 + e2 + e3) * inv;
    }
  }
}

DI void gemm_mainloop(const bf16_t* __restrict__ tokp, size_t ldt, const bf16_t* __restrict__ W, int m0, int n0,
                      unsigned char* lds, f32x4 (&acc)[4][8], int tid) {
  const int lane = tid & 63, wid = tid >> 6, wr = wid >> 2, wc = wid & 3;
  const int wid_s = __builtin_amdgcn_readfirstlane(wid);
  unsigned gA0, gB0;
  {
    const int row = tid >> 3, c = (tid & 7) ^ (row & 7);
    gA0 = (unsigned)((size_t)(m0 + row) * ldt + c * 8);
    const int nt = row >> 4, ii = row & 15, nl = 16 * (ii >> 2) + 4 * nt + (ii & 3);
    gB0 = (unsigned)((n0 + nl) * 1024 + c * 8);
  }
  const unsigned ldt64 = (unsigned)(64 * ldt);
#pragma unroll
  for (int a = 0; a < 4; ++a)
#pragma unroll
    for (int b = 0; b < 8; ++b) acc[a][b] = (f32x4){0.f, 0.f, 0.f, 0.f};
  unsigned char* dma = lds + 1024 * wid_s;
#define GLDS_PART(kt_, st_, i) do { \
      __builtin_amdgcn_global_load_lds((const unsigned*)(tokp + (size_t)((i) * ldt64 + (kt_) * 64) + gA0), (LDSAS unsigned*)(dma + (st_) * 32768 + 8192 * (i)), 16, 0, 0); \
      __builtin_amdgcn_global_load_lds((const unsigned*)(W + (size_t)((i) * 65536 + (kt_) * 64) + gB0), (LDSAS unsigned*)(dma + 65536 + (st_) * 32768 + 8192 * (i)), 16, 0, 0); } while (0)
  const int fr = lane & 15, fq = lane >> 4;
  const unsigned char* tb0 = lds + (128 * wr + fr) * 128 + 16 * (fq ^ (fr & 7));
  const unsigned char* tb1 = lds + (128 * wr + fr) * 128 + 16 * ((4 + fq) ^ (fr & 7));
  const unsigned char* wb0 = lds + 65536 + (64 * wc + fr) * 128 + 16 * (fq ^ (fr & 7));
  const unsigned char* wb1 = lds + 65536 + (64 * wc + fr) * 128 + 16 * ((4 + fq) ^ (fr & 7));
#define LD_W(dst, st_, wb_) _Pragma("unroll") for (int nt = 0; nt < 4; ++nt) dst[nt] = *(const bf16x8*)(wb_ + (st_) * 32768 + nt * 2048)
#define LD_T(dst, st_, mh_, tb_) _Pragma("unroll") for (int mt = 0; mt < 4; ++mt) dst[mt] = *(const bf16x8*)(tb_ + (st_) * 32768 + ((mh_) * 4 + mt) * 2048)
#define MMA(wf_, tf_, mh_) do { __builtin_amdgcn_s_setprio(1); _Pragma("unroll") for (int nt = 0; nt < 4; ++nt) _Pragma("unroll") for (int mt = 0; mt < 4; ++mt) \
    acc[nt][(mh_) * 4 + mt] = mfma16(wf_[nt], tf_[mt], acc[nt][(mh_) * 4 + mt]); __builtin_amdgcn_s_setprio(0); } while (0)
#define SB() __builtin_amdgcn_sched_barrier(0)
  asm volatile("s_waitcnt lgkmcnt(0)" ::: "memory");
  __builtin_amdgcn_s_barrier();
  GLDS_PART(0, 0, 0); GLDS_PART(0, 0, 1); GLDS_PART(0, 0, 2); GLDS_PART(0, 0, 3);
  asm volatile("s_waitcnt vmcnt(0)" ::: "memory");
  __builtin_amdgcn_s_barrier();
  GLDS_PART(1, 1, 0);
  bf16x8 wf0[4], wf1[4], tfA[4], tfB[4];
  LD_W(wf0, 0, wb0); LD_T(tfA, 0, 0, tb0);
  SB();
#define KTILE(cs, ns, k1, k2) do { \
    LD_T(tfB, cs, 1, tb0); GLDS_PART(k1, ns, 1); GLDS_PART(k1, ns, 2);   SB(); \
    MMA(wf0, tfA, 0);                               SB(); \
    LD_W(wf1, cs, wb1); LD_T(tfA, cs, 0, tb1); GLDS_PART(k1, ns, 3);     SB(); \
    MMA(wf0, tfB, 1);                               SB(); \
    LD_T(tfB, cs, 1, tb1);                          SB(); \
    MMA(wf1, tfA, 0);                               SB(); \
    asm volatile("s_waitcnt vmcnt(0) lgkmcnt(0)" ::: "memory"); \
    __builtin_amdgcn_s_barrier();                   SB(); \
    GLDS_PART(k2, cs, 0); LD_W(wf0, ns, wb0); LD_T(tfA, ns, 0, tb0);     SB(); \
    MMA(wf1, tfB, 1);                               SB(); } while (0)
  for (int kp = 0; kp < 8; ++kp) {
    const int ka = 2 * kp + 1, kb = 2 * kp + 2 < 16 ? 2 * kp + 2 : 15, kc = 2 * kp + 3 < 16 ? 2 * kp + 3 : 15;
    KTILE(0, 1, ka, kb);
    KTILE(1, 0, kb, kc);
  }
#undef KTILE
#undef GLDS_PART
#undef LD_W
#undef LD_T
#undef MMA
#undef SB
}

DI void epi_z(const f32x4 (&acc)[4][8], bf16_t* __restrict__ dst, int ldd, const float* __restrict__ ss, int m0, int n0, int tid, int act = 0) {
  asm volatile("" : "+v"(tid));
  const int lane = tid & 63, wid = tid >> 6, wr = wid >> 2, wc = wid & 3, fr = lane & 15, g = lane >> 4;
  const int nw0 = n0 + 64 * wc;
#pragma unroll
  for (int mt = 0; mt < 8; ++mt) {
    const int tok = m0 + 128 * wr + 16 * mt + fr;
    const float rs = rsqrtf(ss[tok] * (1.f / 1024.f) + EPS);
    float v[16];
#pragma unroll
    for (int nt = 0; nt < 4; ++nt)
#pragma unroll
      for (int r = 0; r < 4; ++r) v[4 * nt + r] = acc[nt][mt][r] * rs;
    if (act == 1) {
#pragma unroll
      for (int j = 0; j < 16; ++j) v[j] = v[j] * frcp(1.f + fexp(-v[j]));
    } else if (act == 2) {
#pragma unroll
      for (int j = 0; j < 16; ++j) v[j] = frcp(1.f + fexp(v[j]));
    }
    u32x4 o0 = {pk2(v[0], v[1]), pk2(v[2], v[3]), pk2(v[4], v[5]), pk2(v[6], v[7])};
    u32x4 o1 = {pk2(v[8], v[9]), pk2(v[10], v[11]), pk2(v[12], v[13]), pk2(v[14], v[15])};
    bf16_t* d = dst + (size_t)tok * ldd + nw0 + 16 * g;
    __builtin_nontemporal_store(o0, (u32x4*)d); __builtin_nontemporal_store(o1, (u32x4*)(d + 8));
  }
}

DI void norm_fixup(bf16_t* __restrict__ dst, int ldd, int m0, int n0, const float* __restrict__ normw, float post, bool rope, int tid) {
  asm volatile("" : "+v"(tid));
  asm volatile("s_waitcnt vmcnt(0)" ::: "memory");
  __syncthreads();
#pragma unroll 1
  for (int i = 0; i < 2; ++i) {
    const int row = tid + 512 * i; const int head = row & 3, tok = m0 + (row >> 2);
    bf16_t* d = dst + (size_t)tok * ldd + n0 + head * 64;
    u32x4 raw[8];
#pragma unroll
    for (int j = 0; j < 8; ++j) raw[j] = *(const u32x4*)(d + 8 * j);
    float s = 0.f;
#pragma unroll
    for (int j = 0; j < 8; ++j)
#pragma unroll
      for (int e = 0; e < 4; ++e) { const float a = bflo(raw[j][e]), b = bfhi(raw[j][e]); s += a * a + b * b; }
    const float hr = rsqrtf(s * (1.f / 64.f) + EPS);
    float c8[8], s8[8];
    if (rope) {
      int ss0, S; tok_info(tok, ss0, S);
      const float pos = (float)(tok - ss0);
      const float ifh[8] = {0.1591796875f, 0.030853271484375f, 0.0059814453125f, 0.0011615753173828125f,
                            0.000225067138671875f, 4.363059997558594e-05f, 8.463859558105469e-06f, 1.6409903764724731e-06f};
      const float ifl[8] = {-2.474440771038644e-05f, 1.0491919965716079e-05f, 3.7404001886898186e-06f, -9.116761248151306e-07f,
                            1.1940367805607366e-08f, 1.7352817849314306e-08f, 4.712501500137023e-10f, 4.3588632703261965e-10f};
#pragma unroll
      for (int q = 0; q < 8; ++q) {
        const float ph = pos * ifh[q];
        const float fr_ = (ph - floorf(ph)) + pos * ifl[q];
        s8[q] = __builtin_amdgcn_sinf(fr_); c8[q] = __builtin_amdgcn_cosf(fr_);
      }
    }
#pragma unroll
    for (int j = 0; j < 8; ++j) {
      float v[8];
#pragma unroll
      for (int e = 0; e < 4; ++e) {
        v[2 * e] = bflo(raw[j][e]) * hr * normw[8 * j + 2 * e];
        v[2 * e + 1] = bfhi(raw[j][e]) * hr * normw[8 * j + 2 * e + 1];
      }
      if (rope && j < 2) {
#pragma unroll
        for (int e = 0; e < 4; ++e) {
          const float o0 = bflo(raw[1 - j][e]) * hr * normw[8 * (1 - j) + 2 * e], o1 = bfhi(raw[1 - j][e]) * hr * normw[8 * (1 - j) + 2 * e + 1];
          if (j == 0) { v[2 * e] = v[2 * e] * c8[2 * e] - o0 * s8[2 * e]; v[2 * e + 1] = v[2 * e + 1] * c8[2 * e + 1] - o1 * s8[2 * e + 1]; }
          else { v[2 * e] = v[2 * e] * c8[2 * e] + o0 * s8[2 * e]; v[2 * e + 1] = v[2 * e + 1] * c8[2 * e + 1] + o1 * s8[2 * e + 1]; }
        }
      }
      u32x4 o = {pk2(v[0] * post, v[1] * post), pk2(v[2] * post, v[3] * post), pk2(v[4] * post, v[5] * post), pk2(v[6] * post, v[7] * post)};
      *(u32x4*)(d + 8 * j) = o;
    }
  }
}

DI void epi_out(const f32x4 (&acc)[4][8], const Params& p, int layer, int m0, int n0, int tid) {
  asm volatile("" : "+v"(tid));
  const int lane = tid & 63, wid = tid >> 6, wr = wid >> 2, wc = wid & 3, fr = lane & 15, g = lane >> 4;
  bf16_t* XB = (bf16_t*)(p.ws + OFF_XB);
  float* XSS = (float*)(p.ws + OFF_XSS);
  const int nb = n0 + 64 * wc + 16 * g;
#pragma unroll
  for (int mt = 0; mt < 8; ++mt) {
    const int tok = m0 + 128 * wr + 16 * mt + fr;
    bf16_t* d = XB + (size_t)tok * 1024 + nb;
    float v[16];
    {
      const u32x4 x0 = *(const u32x4*)d, x1 = *(const u32x4*)(d + 8);
#pragma unroll
      for (int nt = 0; nt < 2; ++nt) {
        v[4 * nt + 0] = bflo(x0[2 * nt]) + acc[nt][mt][0]; v[4 * nt + 1] = bfhi(x0[2 * nt]) + acc[nt][mt][1];
        v[4 * nt + 2] = bflo(x0[2 * nt + 1]) + acc[nt][mt][2]; v[4 * nt + 3] = bfhi(x0[2 * nt + 1]) + acc[nt][mt][3];
        v[8 + 4 * nt + 0] = bflo(x1[2 * nt]) + acc[2 + nt][mt][0]; v[8 + 4 * nt + 1] = bfhi(x1[2 * nt]) + acc[2 + nt][mt][1];
        v[8 + 4 * nt + 2] = bflo(x1[2 * nt + 1]) + acc[2 + nt][mt][2]; v[8 + 4 * nt + 3] = bfhi(x1[2 * nt + 1]) + acc[2 + nt][mt][3];
      }
    }
    if (layer == 3) {
      float* od = p.out + (size_t)tok * 1024 + nb;
#pragma unroll
      for (int nt = 0; nt < 4; ++nt) *(float4*)(od + 4 * nt) = make_float4(v[4 * nt], v[4 * nt + 1], v[4 * nt + 2], v[4 * nt + 3]);
    } else {
      float s = 0.f;
#pragma unroll
      for (int j = 0; j < 16; ++j) s += v[j] * v[j];
      u32x4 o0 = {pk2(v[0], v[1]), pk2(v[2], v[3]), pk2(v[4], v[5]), pk2(v[6], v[7])};
      u32x4 o1 = {pk2(v[8], v[9]), pk2(v[10], v[11]), pk2(v[12], v[13]), pk2(v[14], v[15])};
      *(u32x4*)d = o0; *(u32x4*)(d + 8) = o1;
      s += __shfl_xor(s, 16); s += __shfl_xor(s, 32);
      if (g == 0) atomicAdd(XSS + tok, s);
    }
  }
}

DI void phase_inproj(const Params& p, int layer, unsigned char* lds, int tid) {
  unsigned char* ws = p.ws;
  bf16_t* Z = (bf16_t*)(ws + OFF_Z);
  const bf16_t* XB = (const bf16_t*)(ws + OFF_XB);
  const float* XSS = (const float*)(ws + OFF_XSS);
  const bf16_t* WIN = (const bf16_t*)(ws + OFF_WIN) + (size_t)layer * 4096 * 1024;
  constexpr int NT_IN = (T_TOK / 256) * 16;
  const int n_extra = layer == 0 ? 4 * 10 * 2 : 0;
  for (int it = blockIdx.x; it < NT_IN + n_extra; it += gridDim.x) {
    f32x4 acc[4][8];
    if (it < NT_IN) {
      int mt_ = it >> 4, nt_ = it & 15;
      if (gridDim.x == 256) {
        const int r = it >> 8, x = blockIdx.x & 7, j = blockIdx.x >> 3;
        mt_ = r * 16 + (x >> 2) * 8 + (j >> 2);
        nt_ = 4 * (((x & 3) + r / 6) & 3) + (j & 3);
      }
      const int m0 = mt_ * 256, n0 = nt_ * 256;
      gemm_mainloop(XB, 1024, WIN, m0, n0, lds, acc, tid);
      epi_z(acc, Z, NIN, XSS, m0, n0, tid, (n0 < C_FF || n0 >= C_GH) ? 1 : (n0 < C_HI ? 2 : 0));
      if (n0 == C_AQ) norm_fixup(Z, NIN, m0, n0, p.aq_w + layer * 64, 0.125f * 1.4426950408889634f, true, tid);
      else if (n0 == C_AK) norm_fixup(Z, NIN, m0, n0, p.ak_w + layer * 64, 1.f, true, tid);
      else if (n0 == C_MQ) norm_fixup(Z, NIN, m0, n0, p.mq_w + layer * 64, 0.125f * 1.4426950408889634f, false, tid);
    } else {
      const int i = it - NT_IN; const int l = i / 20, r = i % 20, mt_ = r >> 1, nt_ = r & 1, m0 = mt_ * 256, n0 = nt_ * 256;
      const bf16_t* MEMB = (const bf16_t*)(ws + OFF_MEMB);
      const float* MEMSS = (const float*)(ws + OFF_MEMSS);
      const bf16_t* WKV = (const bf16_t*)(ws + OFF_WKV) + (size_t)l * 512 * 1024;
      bf16_t* MKV = (bf16_t*)(ws + OFF_MKV) + (size_t)l * 2560 * 512;
      gemm_mainloop(MEMB, 1024, WKV, m0, n0, lds, acc, tid);
      epi_z(acc, MKV, 512, MEMSS, m0, n0, tid);
      if (n0 == 0) norm_fixup(MKV, 512, m0, n0, p.mk_w + l * 64, 1.f, false, tid);
    }
  }
}

DI void phase_outproj(const Params& p, int layer, unsigned char* lds, int tid) {
  unsigned char* ws = p.ws;
  const bf16_t* Zm = (const bf16_t*)(ws + OFF_Z) + C_GH;
  const bf16_t* WOUT = (const bf16_t*)(ws + OFF_WOUT) + (size_t)layer * 1024 * 1024;
  constexpr int NT_OUT = (T_TOK / 256) * 4;
  for (int it = blockIdx.x; it < NT_OUT; it += gridDim.x) {
    f32x4 acc[4][8];
    int mt_ = it >> 2, nt_ = it & 3;
    if (gridDim.x == 256) {
      const int r = it >> 8, x = blockIdx.x & 7, j = blockIdx.x >> 3;
      mt_ = r * 64 + x * 8 + (j >> 2); nt_ = j & 3;
    }
    const int m0 = mt_ * 256, n0 = nt_ * 256;
    gemm_mainloop(Zm, NIN, WOUT, m0, n0, lds, acc, tid);
    epi_out(acc, p, layer, m0, n0, tid);
  }
}

constexpr int L_QI = 0, L_KE = 17408, L_V = 34816, L_P = 52224, L_TOT = 61440, L_DEC = 63488;
constexpr int RS = 272;
constexpr int PS = 144;

constexpr int SEG_CH = 8;
constexpr int N_SEG = T_TOK / (64 * SEG_CH);
constexpr int N_UNITS = N_SEG * 8;

template <bool FULL>
DI void scan_unit(const Params& p, int layer, int unit, unsigned char* lds, int tid) {
  unsigned char* ws = p.ws;
  bf16_t* Z = (bf16_t*)(ws + OFF_Z);
  float* H = p.out + (size_t)unit * 16384;
  float* DS = p.out + (size_t)N_UNITS * 16384 + unit * 128;
  const float* LB = (const float*)(ws + OFF_LB);
  const int seg = unit >> 3, head = (unit >> 1) & 3, dir = unit & 1;
  const int lane = tid & 63, w = tid >> 6;
  const int r = lane & 31, h = lane >> 5, i16 = lane & 15, gg = (lane >> 4) & 1, q4 = i16 >> 2, p4 = i16 & 3;
  const int cq = tid & 31, tg = tid >> 5;
  const int fcol = (dir ? C_FB : C_FF) + head * 128;
  const f32x4 lbv = *(const f32x4*)(LB + (dir * 4 + layer) * 512 + head * 128 + 4 * cq);
  const f32x4 om = (f32x4){1.f, 1.f, 1.f, 1.f} - lbv;
  float one = 1.f; asm volatile("" : "+v"(one));
  f32x4 dprod = {one, one, one, one};

  f32x16 st[4];
  if (FULL) {
#pragma unroll
    for (int kb = 0; kb < 4; ++kb)
#pragma unroll
      for (int reg = 0; reg < 16; ++reg) st[kb][reg] = H[(32 * kb + crow(reg, h)) * 128 + 32 * w + r];
  } else {
#pragma unroll
    for (int kb = 0; kb < 4; ++kb)
#pragma unroll
      for (int reg = 0; reg < 16; ++reg) st[kb][reg] = 0.f;
  }
  const int srow = tid >> 4, sch = tid & 15;
  u32x4 pf_f[4], pf_v[4], pf_q[4];
  {
    const int c0 = seg * (64 * SEG_CH) + (dir ? SEG_CH - 1 : 0) * 64;
#pragma unroll
    for (int j = 0; j < 4; ++j) {
      const int i = srow + 16 * j; const bf16_t* zr = Z + (size_t)(c0 + (dir ? 63 - i : i)) * NIN + 8 * sch;
      pf_f[j] = __builtin_nontemporal_load((const u32x4*)(zr + fcol)); pf_v[j] = *(const u32x4*)(zr + C_HI + head * 128);
      if (FULL) pf_q[j] = *(const u32x4*)(zr + C_HQ + head * 128);
    }
  }

  for (int cc = 0; cc < SEG_CH; ++cc) {
    const int c0 = seg * (64 * SEG_CH) + (dir ? SEG_CH - 1 - cc : cc) * 64;
    __syncthreads();
#pragma unroll
    for (int j = 0; j < 4; ++j) {
      const int i = srow + 16 * j;
      *(u32x4*)(lds + L_KE + i * RS + 16 * sch) = pf_f[j];
      *(u32x4*)(lds + L_V + i * RS + 16 * sch) = pf_v[j];
      if (FULL) *(u32x4*)(lds + L_QI + i * RS + 16 * sch) = pf_q[j];
    }
    __syncthreads();
    if (cc + 1 < SEG_CH) {
      const int c1 = seg * (64 * SEG_CH) + (dir ? SEG_CH - 2 - cc : cc + 1) * 64;
#pragma unroll
      for (int j = 0; j < 4; ++j) {
        const int i = srow + 16 * j; const bf16_t* zr = Z + (size_t)(c1 + (dir ? 63 - i : i)) * NIN + 8 * sch;
        pf_f[j] = __builtin_nontemporal_load((const u32x4*)(zr + fcol)); pf_v[j] = *(const u32x4*)(zr + C_HI + head * 128);
        if (FULL) pf_q[j] = *(const u32x4*)(zr + C_HQ + head * 128);
      }
    }
    {
      f32x4 t = {one, one, one, one};
#pragma unroll
      for (int ii = 0; ii < 8; ++ii) {
        const u32x2 zz = *(const u32x2*)(lds + L_KE + (8 * tg + ii) * RS + 8 * cq);
        t[0] *= 1.f - om[0] * bflo(zz[0]); t[1] *= 1.f - om[1] * bfhi(zz[0]);
        t[2] *= 1.f - om[2] * bflo(zz[1]); t[3] *= 1.f - om[3] * bfhi(zz[1]);
      }
      *(f32x4*)(lds + L_P + (tg * 128 + 4 * cq) * 4) = t;
    }
    __syncthreads();
    {
      f32x4 eb = {one, one, one, one}, bl = {one, one, one, one};
#pragma unroll
      for (int qq = 0; qq < 8; ++qq) {
        const f32x4 tt = *(const f32x4*)(lds + L_P + (qq * 128 + 4 * cq) * 4);
        if (qq < tg) eb = eb * tt;
        bl = bl * tt;
      }
      if (tg == 0) { *(f32x4*)(lds + L_DEC + 4 * cq * 4) = bl; dprod = dprod * bl; }
#pragma unroll
      for (int ii = 0; ii < 8; ++ii) {
        const int i = 8 * tg + ii;
        const u32x2 zz = *(const u32x2*)(lds + L_KE + i * RS + 8 * cq);
        f32x4 k = {om[0] * bflo(zz[0]), om[1] * bfhi(zz[0]), om[2] * bflo(zz[1]), om[3] * bfhi(zz[1])};
        eb = eb * ((f32x4){1.f, 1.f, 1.f, 1.f} - k);
        f32x4 ke = {k[0] * frcp(fmaxf(eb[0], 1e-30f)), k[1] * frcp(fmaxf(eb[1], 1e-30f)), k[2] * frcp(fmaxf(eb[2], 1e-30f)), k[3] * frcp(fmaxf(eb[3], 1e-30f))};
        *(u32x2*)(lds + L_KE + i * RS + 8 * cq) = (u32x2){pk2(ke[0], ke[1]), pk2(ke[2], ke[3])};
        if (FULL) {
          const u32x2 zq = *(const u32x2*)(lds + L_QI + i * RS + 8 * cq);
          *(u32x2*)(lds + L_QI + i * RS + 8 * cq) = (u32x2){pk2(bflo(zq[0]) * eb[0], bfhi(zq[0]) * eb[1]), pk2(bflo(zq[1]) * eb[2], bfhi(zq[1]) * eb[3])};
        }
      }
    }
    __syncthreads();
    bf16x8 bv[4];
#pragma unroll
    for (int s = 0; s < 4; ++s) {
      const unsigned char* a = lds + L_V + (16 * s + 8 * h + q4) * RS + (32 * w + 16 * gg + 4 * p4) * 2;
      bv[s] = cat4(trread(a), trread(a + 4 * RS));
    }
    if (FULL) {
      if (w < 3) {
        const int tb = w == 0 ? 0 : 1, sb = w == 2 ? 1 : 0;
        f32x16 sc;
#pragma unroll
        for (int reg = 0; reg < 16; ++reg) sc[reg] = 0.f;
#pragma unroll
        for (int s = 0; s < 8; ++s) {
          bf16x8 a = *(const bf16x8*)(lds + L_QI + (32 * tb + r) * RS + (16 * s + 8 * h) * 2);
          bf16x8 b = *(const bf16x8*)(lds + L_KE + (32 * sb + r) * RS + (16 * s + 8 * h) * 2);
          sc = mfma32(b, a, sc);
        }
        const int t = 32 * tb + r;
#pragma unroll
        for (int rq = 0; rq < 4; ++rq) {
          const int s0 = 32 * sb + 8 * rq + 4 * h;
          float v0 = s0 <= t ? sc[4 * rq] : 0.f, v1 = s0 + 1 <= t ? sc[4 * rq + 1] : 0.f, v2 = s0 + 2 <= t ? sc[4 * rq + 2] : 0.f, v3 = s0 + 3 <= t ? sc[4 * rq + 3] : 0.f;
          *(u32x2*)(lds + L_P + t * PS + s0 * 2) = (u32x2){pk2(v0, v1), pk2(v2, v3)};
        }
      }
      __syncthreads();
#pragma unroll
      for (int tb = 0; tb < 2; ++tb) {
        f32x16 o;
#pragma unroll
        for (int reg = 0; reg < 16; ++reg) o[reg] = 0.f;
#pragma unroll
        for (int kb = 0; kb < 4; ++kb)
#pragma unroll
          for (int s2 = 0; s2 < 2; ++s2) {
            u32x4 pb = {pk2(st[kb][8 * s2 + 0], st[kb][8 * s2 + 1]), pk2(st[kb][8 * s2 + 2], st[kb][8 * s2 + 3]),
                        pk2(st[kb][8 * s2 + 4], st[kb][8 * s2 + 5]), pk2(st[kb][8 * s2 + 6], st[kb][8 * s2 + 7])};
            bf16x8 bst = __builtin_bit_cast(bf16x8, pb);
            const unsigned char* a = lds + L_QI + (32 * tb + r) * RS + (32 * kb + 16 * s2 + 4 * h) * 2;
            s16x4 lo = *(const s16x4*)a, hi = *(const s16x4*)(a + 16);
            o = mfma32(bst, cat4(lo, hi), o);
            if (s2 == 1 && (kb & 1)) __builtin_amdgcn_sched_barrier(0);
          }
#pragma unroll
        for (int s = 0; s < 4; ++s) {
          if (tb == 0 && s >= 2) continue;
          bf16x8 a = *(const bf16x8*)(lds + L_P + (32 * tb + r) * PS + (16 * s + 8 * h) * 2);
          o = mfma32(bv[s], a, o);
        }
#pragma unroll
        for (int rq = 0; rq < 4; ++rq) {
          *(u32x2*)(lds + L_V + (32 * tb + r) * RS + (32 * w + 8 * rq + 4 * h) * 2) = (u32x2){pk2(o[4 * rq], o[4 * rq + 1]), pk2(o[4 * rq + 2], o[4 * rq + 3])};
        }
        __builtin_amdgcn_sched_barrier(0);
      }
      __syncthreads();
#pragma unroll
      for (int j = 0; j < 4; ++j) {
        const int i = srow + 16 * j; const int tok = c0 + (dir ? 63 - i : i);
        *(u32x4*)(Z + (size_t)tok * NIN + fcol + 8 * sch) = *(const u32x4*)(lds + L_V + i * RS + 16 * sch);
      }
    }
#pragma unroll
    for (int kb = 0; kb < 4; ++kb) {
#pragma unroll
      for (int s = 0; s < 4; ++s) {
        const unsigned char* a = lds + L_KE + (16 * s + 8 * h + q4) * RS + (32 * kb + 16 * gg + 4 * p4) * 2;
        bf16x8 af = cat4(trread(a), trread(a + 4 * RS));
        st[kb] = mfma32(af, bv[s], st[kb]);
      }
#pragma unroll
      for (int rq = 0; rq < 4; ++rq) {
        f32x4 d = *(const f32x4*)(lds + L_DEC + (32 * kb + 8 * rq + 4 * h) * 4);
        st[kb][4 * rq + 0] *= d[0]; st[kb][4 * rq + 1] *= d[1]; st[kb][4 * rq + 2] *= d[2]; st[kb][4 * rq + 3] *= d[3];
      }
      __builtin_amdgcn_sched_barrier(0);
    }
  }
  if (!FULL) {
#pragma unroll
    for (int kb = 0; kb < 4; ++kb)
#pragma unroll
      for (int reg = 0; reg < 16; ++reg) H[(32 * kb + crow(reg, h)) * 128 + 32 * w + r] = st[kb][reg];
    if (tg == 0) *(f32x4*)(DS + 4 * cq) = dprod;
  }
}

DI void phase_carry(const Params& p, int vb, int vg, int tid) {
  unsigned char* ws = p.ws;
  float* H = p.out;
  const float* DS = p.out + (size_t)N_UNITS * 16384;
  constexpr int SPP = 8192 / (64 * SEG_CH), SPS = 16384 / (64 * SEG_CH);
  for (int it = vb; it < 80 * 16; it += vg) {
    const int sc = it >> 4, sl = it & 15;
    const int seqi = sc >> 3, head = (sc >> 1) & 3, dir = sc & 1;
    const int seg0 = seqi < 8 ? SPP * seqi : 8 * SPP + SPS * (seqi - 8), nseg = seqi < 8 ? SPP : SPS;
    const int e = 1024 * sl + 4 * tid, k = e >> 7;
    f32x4 carry = {0.f, 0.f, 0.f, 0.f};
    for (int j0 = 0; j0 < nseg; j0 += 8) {
      f32x4 ev[8]; float dv[8];
#pragma unroll
      for (int q = 0; q < 8; ++q) {
        const int jj = j0 + q; const int seg = dir ? seg0 + nseg - 1 - jj : seg0 + jj;
        const int unit = seg * 8 + head * 2 + dir;
        ev[q] = *(const f32x4*)(H + (size_t)unit * 16384 + e);
        dv[q] = DS[unit * 128 + k];
      }
#pragma unroll
      for (int q = 0; q < 8; ++q) {
        const int jj = j0 + q; const int seg = dir ? seg0 + nseg - 1 - jj : seg0 + jj;
        const int unit = seg * 8 + head * 2 + dir;
        *(f32x4*)(H + (size_t)unit * 16384 + e) = carry;
        carry = carry * dv[q] + ev[q];
      }
    }
  }
}

DI void softmax_step(const f32x4& sa, const f32x4& sb, float& m_run, float& l_run, f32x4 (&O)[4], bf16x8& pf) {
  float mx = fmaxf(fmaxf(fmaxf(sa[0], sa[1]), fmaxf(sa[2], sa[3])), fmaxf(fmaxf(sb[0], sb[1]), fmaxf(sb[2], sb[3])));
  if (__builtin_amdgcn_ballot_w64(mx > m_run + 8.f) != 0ull) {
    mx = fmaxf(mx, __shfl_xor(mx, 16)); mx = fmaxf(mx, __shfl_xor(mx, 32));
    const float m_new = fmaxf(m_run, mx);
    const float alpha = __builtin_amdgcn_exp2f(m_run - m_new);
    m_run = m_new;
    l_run *= alpha;
#pragma unroll
    for (int dt = 0; dt < 4; ++dt) O[dt] = O[dt] * alpha;
  }
  float pa[4], pb[4], ps = 0.f;
#pragma unroll
  for (int reg = 0; reg < 4; ++reg) {
    pa[reg] = __builtin_amdgcn_exp2f(sa[reg] - m_run);
    pb[reg] = __builtin_amdgcn_exp2f(sb[reg] - m_run);
    ps += pa[reg] + pb[reg];
  }
  l_run += ps;
  u32x4 pp = {pk2(pa[0], pa[1]), pk2(pa[2], pa[3]), pk2(pb[0], pb[1]), pk2(pb[2], pb[3])};
  pf = __builtin_bit_cast(bf16x8, pp);
}

DI void attn_finish(bf16_t* op, float l_run, const f32x4 (&O)[4]) {
  float lt = l_run; lt += __shfl_xor(lt, 16); lt += __shfl_xor(lt, 32);
  const float inv = 1.f / lt;
#pragma unroll
  for (int dt = 0; dt < 4; ++dt) {
    u32x2 gv = *(const u32x2*)(op + 16 * dt);
    float g0 = bflo(gv[0]), g1 = bfhi(gv[0]), g2 = bflo(gv[1]), g3 = bfhi(gv[1]);
    u32x2 o = {pk2(O[dt][0] * inv * g0, O[dt][1] * inv * g1), pk2(O[dt][2] * inv * g2, O[dt][3] * inv * g3)};
    *(u32x2*)(op + 16 * dt) = o;
  }
}

DI void attn_dilated(const Params& p, int gidx, unsigned char* wl, int lane) {
  bf16_t* Z = (bf16_t*)(p.ws + OFF_Z);
  const int u = lane & 15, g = lane >> 4, q4 = u >> 2, p4 = u & 3;
  const int off = gidx & 15, head = (gidx >> 4) & 3, t0 = (gidx >> 6) * 256;
  int seq_start, S; tok_info(t0, seq_start, S);
  const int pos0 = t0 - seq_start + off, qtok = seq_start + pos0 + 16 * u;
  const bf16_t* kbase = Z + (size_t)seq_start * NIN + C_AK + head * 64 + 8 * g;
  const bf16_t* vbase = Z + (size_t)seq_start * NIN + C_AV + head * 64 + 8 * (lane & 7);
  const bf16_t* qp = Z + (size_t)qtok * NIN + C_AQ + head * 64 + 8 * g;
  const bf16x8 qf0 = *(const bf16x8*)qp, qf1 = *(const bf16x8*)(qp + 32);
  float m_run = -1e4f, l_run = 0.f;
  f32x4 O[4];
#pragma unroll
  for (int dt = 0; dt < 4; ++dt) O[dt] = (f32x4){0.f, 0.f, 0.f, 0.f};
  auto step_params = [&](int s, int& stride, int& fk) {
    if (s < 5) { stride = 16; fk = pos0 - 1024 + 512 * s; }
    else if (s < 11) { stride = 4; fk = pos0 - 256 + 128 * (s - 5); }
    else { stride = 1; fk = pos0 - 64 + 32 * (s - 11); }
  };
  auto pat_range = [&](int stride, int c, int& jlo, int& span) {
    const int t = 64 * stride - pos0;
    const int jmin = t <= 0 ? 0 : (t + stride - 1) / stride;
    const int jmax = (S + 64 * stride - pos0 - 1) / stride;
    jlo = max(c * u, jmin); span = min(c * u + 128, jmax) - jlo;
  };
  int jlo3, sp3, jlo2, sp2, jlo1, sp1;
  pat_range(16, 1, jlo3, sp3); pat_range(4, 4, jlo2, sp2); pat_range(1, 16, jlo1, sp1);
  auto load_step = [&](int s, bf16x8 (&kf_)[4], u32x4 (&vv_)[4]) {
    int stride, fk; step_params(s, stride, fk);
    const int kca = min(max(fk + stride * u, 0), S - 1), kcb = min(max(fk + stride * (u + 16), 0), S - 1);
    const bf16_t* ka = kbase + (size_t)kca * NIN; const bf16_t* kb = kbase + (size_t)kcb * NIN;
    kf_[0] = *(const bf16x8*)ka; kf_[1] = *(const bf16x8*)(ka + 32); kf_[2] = *(const bf16x8*)kb; kf_[3] = *(const bf16x8*)(kb + 32);
#pragma unroll
    for (int j = 0; j < 4; ++j) {
      const int kv = min(max(fk + stride * ((lane >> 3) + 8 * j), 0), S - 1);
      vv_[j] = *(const u32x4*)(vbase + (size_t)kv * NIN);
    }
  };
  auto compute_step = [&](int s, const bf16x8 (&kf_)[4], const u32x4 (&vv_)[4]) {
    f32x4 sa = {0.f, 0.f, 0.f, 0.f}, sb = {0.f, 0.f, 0.f, 0.f};
    sa = mfma16(kf_[0], qf0, sa); sa = mfma16(kf_[1], qf1, sa);
    sb = mfma16(kf_[2], qf0, sb); sb = mfma16(kf_[3], qf1, sb);
    CBAR();
#pragma unroll
    for (int j = 0; j < 4; ++j) *(u32x4*)(wl + ((lane >> 3) + 8 * j) * 144 + 16 * (lane & 7)) = vv_[j];
    CBAR();
    int jb, span;
    if (s < 5) { jb = 32 * s + 4 * g - jlo3; span = sp3; }
    else if (s < 11) { jb = 32 * (s - 5) + 4 * g - jlo2; span = sp2; }
    else { jb = 32 * (s - 11) + 4 * g - jlo1; span = sp1; }
#pragma unroll
    for (int reg = 0; reg < 4; ++reg) {
      sa[reg] = (unsigned)(jb + reg) <= (unsigned)span ? sa[reg] : -1e30f;
      sb[reg] = (unsigned)(jb + reg + 16) <= (unsigned)span ? sb[reg] : -1e30f;
    }
    bf16x8 pf;
    softmax_step(sa, sb, m_run, l_run, O, pf);
#pragma unroll
    for (int dt = 0; dt < 4; ++dt) {
      const unsigned char* a = wl + (4 * g + q4) * 144 + (16 * dt + 4 * p4) * 2;
      bf16x8 vf = cat4(trread(a), trread(a + 16 * 144));
      O[dt] = mfma16(vf, pf, O[dt]);
    }
    CBAR();
  };
  bf16x8 kfA[4], kfB[4]; u32x4 vvA[4], vvB[4];
  load_step(0, kfA, vvA);
  for (int s = 0; s < 22; s += 2) {
    load_step(s + 1, kfB, vvB);
    compute_step(s, kfA, vvA);
    load_step(s + 2, kfA, vvA);
    compute_step(s + 1, kfB, vvB);
  }
  compute_step(22, kfA, vvA);
  attn_finish(Z + (size_t)qtok * NIN + C_GA + head * 64 + 4 * g, l_run, O);
}

constexpr int L_MK = 0, L_MV = 32768;
DI void attn_mem_item(const Params& p, int layer, int item, unsigned char* lds, int tid) {
  bf16_t* Z = (bf16_t*)(p.ws + OFF_Z);
  const int lane = tid & 63, wid = tid >> 6;
  const int u = lane & 15, g = lane >> 4, q4 = u >> 2, p4 = u & 3;
  const int head = item & 3, t0 = (item >> 2) * 256;
  const int b = t0 < T_PROMPT ? (t0 >> 13) : 8 + ((t0 - T_PROMPT) >> 14);
  const bf16_t* MKV = (const bf16_t*)(p.ws + OFF_MKV) + ((size_t)layer * 2560 + b * 256) * 512 + head * 64;
  __syncthreads();
#pragma unroll
  for (int j = 0; j < 8; ++j) {
    const int q = tid + 256 * j; const int row = q >> 3, c = q & 7;
    u32x4 kv = *(const u32x4*)(MKV + (size_t)row * 512 + 8 * c);
    u32x4 vv = *(const u32x4*)(MKV + (size_t)row * 512 + 256 + 8 * c);
    *(u32x4*)(lds + L_MK + row * 128 + 16 * (c ^ (row & 7))) = kv;
    *(u32x4*)(lds + L_MV + row * 128 + 16 * ((((c >> 1) ^ ((row >> 1) & 3)) << 1) | (c & 1))) = vv;
  }
  __syncthreads();
  for (int gp = 0; gp < 2; ++gp) {
    int qtok[2]; bf16x8 qf0[2], qf1[2]; float m_run[2], l_run[2]; f32x4 O[2][4];
#pragma unroll
    for (int e = 0; e < 2; ++e) {
      qtok[e] = t0 + (wid * 4 + gp * 2 + e) * 16 + u;
      const bf16_t* qp = Z + (size_t)qtok[e] * NIN + C_MQ + head * 64 + 8 * g;
      qf0[e] = *(const bf16x8*)qp; qf1[e] = *(const bf16x8*)(qp + 32);
      m_run[e] = -1e4f; l_run[e] = 0.f;
#pragma unroll
      for (int dt = 0; dt < 4; ++dt) O[e][dt] = (f32x4){0.f, 0.f, 0.f, 0.f};
    }
#pragma unroll 2
    for (int s = 0; s < 8; ++s) {
      const int ra = 32 * s + u, rb = ra + 16;
      const bf16x8 ka0 = *(const bf16x8*)(lds + L_MK + ra * 128 + 16 * (g ^ (ra & 7)));
      const bf16x8 ka1 = *(const bf16x8*)(lds + L_MK + ra * 128 + 16 * ((4 + g) ^ (ra & 7)));
      const bf16x8 kb0 = *(const bf16x8*)(lds + L_MK + rb * 128 + 16 * (g ^ (rb & 7)));
      const bf16x8 kb1 = *(const bf16x8*)(lds + L_MK + rb * 128 + 16 * ((4 + g) ^ (rb & 7)));
      bf16x8 pf[2];
#pragma unroll
      for (int e = 0; e < 2; ++e) {
        f32x4 sa = {0.f, 0.f, 0.f, 0.f}, sb = {0.f, 0.f, 0.f, 0.f};
        sa = mfma16(ka0, qf0[e], sa); sa = mfma16(ka1, qf1[e], sa);
        sb = mfma16(kb0, qf0[e], sb); sb = mfma16(kb1, qf1[e], sb);
        softmax_step(sa, sb, m_run[e], l_run[e], O[e], pf[e]);
      }
      const int r1 = 32 * s + 4 * g + q4, r2 = r1 + 16;
#pragma unroll
      for (int dt = 0; dt < 4; ++dt) {
        const s16x4 lo = trread(lds + L_MV + r1 * 128 + 32 * (dt ^ ((r1 >> 1) & 3)) + 8 * p4);
        const s16x4 hi = trread(lds + L_MV + r2 * 128 + 32 * (dt ^ ((r2 >> 1) & 3)) + 8 * p4);
        const bf16x8 vf = cat4(lo, hi);
        O[0][dt] = mfma16(vf, pf[0], O[0][dt]);
        O[1][dt] = mfma16(vf, pf[1], O[1][dt]);
      }
    }
#pragma unroll
    for (int e = 0; e < 2; ++e) attn_finish(Z + (size_t)qtok[e] * NIN + C_GM + head * 64 + 4 * g, l_run[e], O[e]);
  }
}

DI void phase_combine(const Params& p, int layer, int vb, int vg, int tid) {
  bf16_t* Z = (bf16_t*)(p.ws + OFF_Z);
  const int lane = tid & 63, wid = tid >> 6;
  const float* ow = p.hg_onorm_w + layer * 128 + ((8 * lane) & 127);
  float wv[8];
#pragma unroll
  for (int j = 0; j < 8; ++j) wv[j] = ow[j];
  for (int it = vb; it < T_TOK / 4; it += vg) {
    const int tok = it * 4 + wid;
    bf16_t* zr = Z + (size_t)tok * NIN;
    u32x4 a = *(const u32x4*)(zr + C_FF + 8 * lane), b = *(const u32x4*)(zr + C_FB + 8 * lane), gt = *(const u32x4*)(zr + C_GH + 8 * lane);
    float o[8]; float s = 0.f;
#pragma unroll
    for (int j = 0; j < 4; ++j) { o[2 * j] = bflo(a[j]) + bflo(b[j]); o[2 * j + 1] = bfhi(a[j]) + bfhi(b[j]); }
#pragma unroll
    for (int j = 0; j < 8; ++j) s += o[j] * o[j];
    s += __shfl_xor(s, 1); s += __shfl_xor(s, 2); s += __shfl_xor(s, 4); s += __shfl_xor(s, 8);
    const float rstd = rsqrtf(s * (1.f / 128.f) + EPS);
    float res[8];
#pragma unroll
    for (int j = 0; j < 4; ++j) {
      res[2 * j] = o[2 * j] * rstd * wv[2 * j] * bflo(gt[j]);
      res[2 * j + 1] = o[2 * j + 1] * rstd * wv[2 * j + 1] * bfhi(gt[j]);
    }
    u32x4 ov = {pk2(res[0], res[1]), pk2(res[2], res[3]), pk2(res[4], res[5]), pk2(res[6], res[7])};
    *(u32x4*)(zr + C_GH + 8 * lane) = ov;
  }
}


#define XB_TMO      128
#define XB_XCNT(j)  (256  + 64 * (j))
#define XB_XSUB(j)  (1280 + 64 * (j))
#define XB_XGEN(j)  (2304 + 64 * (j))
#define XB_TOP      3328
#define XB_TOPGEN   3392
#define XCD_BAR_WORDS 3456
#define XB_SPIN_CAP (1u << 20)
DI unsigned xb_ld(unsigned* p) { return __hip_atomic_load(p, __ATOMIC_RELAXED, __HIP_MEMORY_SCOPE_AGENT); }
DI unsigned xb_add(unsigned* p, unsigned v) { return __hip_atomic_fetch_add(p, v, __ATOMIC_RELAXED, __HIP_MEMORY_SCOPE_AGENT); }
DI unsigned xb_xcc_id() { return (unsigned)__builtin_amdgcn_s_getreg((3 << 11) | 20) & 0xFu; }
#define XB_SPIN(cond, bar) do { unsigned _sp = 0; while (cond) { __builtin_amdgcn_s_sleep(1); \
    if ((++_sp & 255u) == 0u) { if (xb_ld(&(bar)[XB_TMO])) break; if (_sp > XB_SPIN_CAP) { atomicAdd(&(bar)[XB_TMO], 1u); break; } } } } while (0)
struct XcdBarrier { unsigned* bar; unsigned x; unsigned nloc, nx; };
DI void xcd_barrier_complete(unsigned* bar, unsigned x, unsigned& nloc, unsigned& nx) {
  const unsigned G = gridDim.x * gridDim.y * gridDim.z;
  unsigned sum, cnt, mine, sp = 0u;
  for (;;) {
    sum = 0u; cnt = 0u; mine = 0u;
#pragma unroll
    for (unsigned j = 0; j < 16; ++j) { const unsigned c = xb_ld(&bar[XB_XCNT(j)]); sum += c; cnt += (c > 0u) ? 1u : 0u; mine = (j == x) ? c : mine; }
    if (sum == G) break;
    __builtin_amdgcn_s_sleep(1);
    if ((++sp & 255u) == 0u) { if (xb_ld(&bar[XB_TMO])) break; if (sp > XB_SPIN_CAP) { atomicAdd(&bar[XB_TMO], 1u); break; } }
  }
  nloc = mine > 0u ? mine : 1u; nx = cnt > 0u ? cnt : 1u;
}
DI void xcd_barrier(unsigned* bar_) {
  asm volatile("s_waitcnt vmcnt(0)" ::: "memory");
  __syncthreads();
  if (threadIdx.x == 0) {
    unsigned* bar = bar_;
    __builtin_amdgcn_s_waitcnt(0);
    const unsigned bx = xb_xcc_id();
    unsigned nloc, nx; xcd_barrier_complete(bar, bx, nloc, nx);
    const unsigned old = xb_add(&bar[XB_XSUB(bx)], 1u);
    const unsigned gen = old / nloc;
    if (old + 1u == (gen + 1u) * nloc) {
      __builtin_amdgcn_fence(__ATOMIC_RELEASE, "agent");
      asm volatile("s_waitcnt vmcnt(0)" ::: "memory");
      const unsigned og = xb_add(&bar[XB_TOP], 1u);
      const unsigned tg = og / nx;
      if (og + 1u == (tg + 1u) * nx) xb_add(&bar[XB_TOPGEN], 1u);
      else XB_SPIN(xb_ld(&bar[XB_TOPGEN]) == tg, bar);
      __builtin_amdgcn_fence(__ATOMIC_ACQUIRE, "agent");
      xb_add(&bar[XB_XGEN(bx)], 1u);
      asm volatile("s_waitcnt vmcnt(0)" ::: "memory");
    } else {
      XB_SPIN(xb_ld(&bar[XB_XGEN(bx)]) == gen, bar);
      __builtin_amdgcn_fence(__ATOMIC_ACQUIRE, "agent");
      asm volatile("s_waitcnt vmcnt(0)" ::: "memory");
    }
  }
  __syncthreads();
}

__global__ void __launch_bounds__(512) fwd_megakernel(Params p) {
  cg::grid_group grid = cg::this_grid();
  extern __shared__ __attribute__((aligned(16))) unsigned char lds[];

  const int wave_u = __builtin_amdgcn_readfirstlane((int)(threadIdx.x >> 6));
#define OPAQUE_TID() ({ int l_; asm volatile("v_mbcnt_lo_u32_b32 %0, -1, 0\n\tv_mbcnt_hi_u32_b32 %0, -1, %0" : "=v"(l_)); wave_u * 64 + l_; })
#define VSPLIT() const int t512 = OPAQUE_TID(); const int tid = t512 & 255, hb = __builtin_amdgcn_readfirstlane(t512 >> 8); const int vb = blockIdx.x * 2 + hb, vg = gridDim.x * 2; unsigned char* ldh = lds + hb * 65536; (void)vb; (void)vg; (void)ldh; (void)tid;
  if (threadIdx.x == 0) (void)xb_add(&((unsigned*)(p.ws + OFF_BAR))[XB_XCNT(xb_xcc_id())], 1u);
  { VSPLIT(); phase_prep(p, ldh, vb, vg, tid); }
  grid.sync();
  for (int layer = 0; layer < 4; ++layer) {
    phase_inproj(p, layer, lds, OPAQUE_TID());
    xcd_barrier((unsigned*)(p.ws + OFF_BAR));
    {
      VSPLIT();
      float* XSS = (float*)(p.ws + OFF_XSS);
#pragma unroll
      for (int k = 0; k < 8; ++k) { const int i = vb * 256 + tid + k * vg * 256; if (i < T_TOK) XSS[i] = 0.f; }
      constexpr int N_S1 = N_UNITS, N_AT = 6144;
      for (int it = vb; it < N_S1 + N_AT; it += vg) {
        if (it < N_S1) scan_unit<false>(p, layer, it, ldh, tid);
        else {
          int ai = it - N_S1;
          if (gridDim.x == 256) {
            const int k = ai >> 9, x = (vb >> 1) & 7, j = (vb >> 4) * 2 + (vb & 1);
            ai = (((k * 8 + x) * 4 + (j >> 4)) << 4) + (j & 15);
          }
          __syncthreads(); attn_dilated(p, ai * 4 + (tid >> 6), ldh + (tid >> 6) * 4608, tid & 63);
        }
      }
    }
    xcd_barrier((unsigned*)(p.ws + OFF_BAR));
    {
      VSPLIT();
      phase_carry(p, vb, vg, tid);
      constexpr int N_MEM = (T_TOK / 256) * 4;
      for (int it = vb; it < N_MEM; it += vg) attn_mem_item(p, layer, it, ldh, tid);
    }
    xcd_barrier((unsigned*)(p.ws + OFF_BAR));
    {
      VSPLIT();
      for (int it = vb; it < N_UNITS; it += vg) scan_unit<true>(p, layer, it, ldh, tid);
    }
    xcd_barrier((unsigned*)(p.ws + OFF_BAR));
    { VSPLIT(); phase_combine(p, layer, vb, vg, tid); }
    xcd_barrier((unsigned*)(p.ws + OFF_BAR));
    phase_outproj(p, layer, lds, OPAQUE_TID());
    if (layer < 3) xcd_barrier((unsigned*)(p.ws + OFF_BAR));
  }
}

extern "C" void kernel_launch(void* const* d_in, const int* in_sizes, int n_in, void* d_out, int out_size, void* d_ws,
                              size_t ws_size, hipStream_t stream) {
  if (ws_size < WS_NEED) { fprintf(stderr, "workspace too small: %zu < %zu\n", ws_size, (size_t)WS_NEED); return; }
  constexpr int kDynLds = 131072;
  static int grid_blocks = 0;
  if (!grid_blocks) {
    int dev = 0, cus = 0, per_cu = 0;
    (void)hipGetDevice(&dev);
    (void)hipDeviceGetAttribute(&cus, hipDeviceAttributeMultiprocessorCount, dev);
    if (hipFuncSetAttribute((const void*)fwd_megakernel, hipFuncAttributeMaxDynamicSharedMemorySize, kDynLds) != hipSuccess) {
      fprintf(stderr, "hipFuncSetAttribute failed\n"); grid_blocks = -1; return;
    }
    (void)hipOccupancyMaxActiveBlocksPerMultiprocessor(&per_cu, fwd_megakernel, 512, kDynLds);
    if (per_cu < 1) fprintf(stderr, "occupancy query reports %d blocks per CU\n", per_cu);
    grid_blocks = cus;
  }
  if (grid_blocks < 0) return;
  Params p{};
  p.x_prompt = (const float*)d_in[0]; p.x_sample = (const float*)d_in[1]; p.mem_prompt = (const float*)d_in[2]; p.mem_sample = (const float*)d_in[3];
  p.norm_w = (const float*)d_in[4]; p.w_in = (const float*)d_in[5]; p.lb_fwd = (const float*)d_in[6]; p.lb_bwd = (const float*)d_in[7];
  p.hg_onorm_w = (const float*)d_in[8]; p.aq_w = (const float*)d_in[9]; p.ak_w = (const float*)d_in[10]; p.mem_norm_w = (const float*)d_in[11];
  p.mem_wkv = (const float*)d_in[12]; p.mq_w = (const float*)d_in[13]; p.mk_w = (const float*)d_in[14]; p.w_out = (const float*)d_in[15];
  p.out = (float*)d_out; p.ws = (unsigned char*)d_ws;
  (void)hipMemsetAsync((unsigned char*)d_ws + OFF_BAR, 0, SZ_BAR, stream);
  void* args[] = {&p};
  hipError_t e = hipLaunchCooperativeKernel((void*)fwd_megakernel, dim3(grid_blocks), dim3(512), args, kDynLds, stream);
  if (e != hipSuccess) fprintf(stderr, "cooperative launch failed: %s (grid %d)\n", hipGetErrorString(e), grid_blocks);
}
```

```cpp
#include <hip/hip_runtime.h>
#include <hip/hip_cooperative_groups.h>
#include <cstdio>
#include <cstdint>
namespace cg = cooperative_groups;

#define DI __device__ __forceinline__
typedef unsigned short bf16_t;
typedef short bf16x8 __attribute__((ext_vector_type(8)));
typedef short s16x4 __attribute__((ext_vector_type(4)));
typedef float f32x4 __attribute__((ext_vector_type(4)));
typedef float f32x16 __attribute__((ext_vector_type(16)));
typedef float f2v __attribute__((ext_vector_type(2)));
typedef __bf16 bf2v __attribute__((ext_vector_type(2)));
typedef unsigned u32x4 __attribute__((ext_vector_type(4)));
typedef unsigned u32x2 __attribute__((ext_vector_type(2)));
#define LDSAS __attribute__((address_space(3)))

#ifndef REP_INPROJ
#define REP_INPROJ 1
#endif
#ifndef REP_S1
#define REP_S1 1
#endif
constexpr int T_TOK = 98304;
constexpr int T_PROMPT = 65536;
constexpr int NIN = 4096;
constexpr float EPS = 1e-6f;

constexpr size_t OFF_Z = 0;
constexpr size_t SZ_Z = (size_t)T_TOK * NIN * 2;
constexpr size_t OFF_XB = OFF_Z + SZ_Z;
constexpr size_t SZ_XB = (size_t)T_TOK * 1024 * 2;
constexpr size_t OFF_H = OFF_XB;
constexpr size_t SZ_H = (size_t)1536 * 16384 * 4;
constexpr size_t OFF_DS = OFF_H + SZ_H;
constexpr size_t OFF_WIN = OFF_XB + SZ_XB;
constexpr size_t SZ_WIN = (size_t)4 * 4096 * 1024 * 2;
constexpr size_t OFF_WOUT = OFF_WIN + SZ_WIN;
constexpr size_t SZ_WOUT = (size_t)4 * 1024 * 1024 * 2;
constexpr size_t OFF_WKV = OFF_WOUT + SZ_WOUT;
constexpr size_t SZ_WKV = (size_t)4 * 512 * 1024 * 2;
constexpr size_t OFF_MEMB = OFF_WKV + SZ_WKV;
constexpr size_t SZ_MEMB = (size_t)2560 * 1024 * 2;
constexpr size_t OFF_MKV = OFF_MEMB + SZ_MEMB;
constexpr size_t SZ_MKV = (size_t)4 * 2560 * 512 * 2;
constexpr size_t OFF_XSS = OFF_MKV + SZ_MKV;
constexpr size_t SZ_XSS = (size_t)T_TOK * 4;
constexpr size_t OFF_MEMSS = OFF_XSS + SZ_XSS;
constexpr size_t SZ_MEMSS = 2560 * 4;
constexpr size_t OFF_LB = OFF_MEMSS + SZ_MEMSS;
constexpr size_t SZ_LB = 2 * 4 * 512 * 4;
constexpr size_t OFF_BAR = OFF_LB + SZ_LB;
constexpr size_t SZ_BAR = 3456 * 4;
constexpr size_t WS_NEED = OFF_BAR + SZ_BAR;

constexpr int C_HQ = 0, C_FF = 512, C_FB = 1024, C_HI = 1536, C_AQ = 2048, C_AK = 2304, C_AV = 2560, C_MQ = 2816,
              C_GH = 3072, C_GA = 3584, C_GM = 3840;

struct Params {
  const float* x_prompt; const float* x_sample; const float* mem_prompt; const float* mem_sample;
  const float* norm_w; const float* w_in; const float* lb_fwd; const float* lb_bwd; const float* hg_onorm_w;
  const float* aq_w; const float* ak_w; const float* mem_norm_w; const float* mem_wkv; const float* mq_w; const float* mk_w;
  const float* w_out;
  float* out; unsigned char* ws;
};

DI unsigned pk2(float a, float b) { f2v v = {a, b}; bf2v r = __builtin_convertvector(v, bf2v); return __builtin_bit_cast(unsigned, r); }
DI float bflo(unsigned u) { return __uint_as_float(u << 16); }
DI float bfhi(unsigned u) { return __uint_as_float(u & 0xffff0000u); }
DI float bf2f(bf16_t v) { return __uint_as_float(((unsigned)v) << 16); }
DI bf16_t f2bf(float a) { return (bf16_t)(pk2(a, 0.f) & 0xffffu); }
DI float fexp(float x) { return __expf(x); }
DI float frcp(float x) { return __builtin_amdgcn_rcpf(x); }
DI float silu(float x) { return x * frcp(1.f + fexp(-x)); }
DI f32x4 mfma16(bf16x8 a, bf16x8 b, f32x4 c) { return __builtin_amdgcn_mfma_f32_16x16x32_bf16(a, b, c, 0, 0, 0); }
DI f32x16 mfma32(bf16x8 a, bf16x8 b, f32x16 c) { return __builtin_amdgcn_mfma_f32_32x32x16_bf16(a, b, c, 0, 0, 0); }
DI s16x4 trread(const unsigned char* p) { return __builtin_amdgcn_ds_read_tr16_b64_v4i16((LDSAS s16x4*)p); }
DI bf16x8 cat4(s16x4 lo, s16x4 hi) { return __builtin_shufflevector(lo, hi, 0, 1, 2, 3, 4, 5, 6, 7); }
DI int crow(int reg, int h) { return (reg & 3) + 8 * (reg >> 2) + 4 * h; }
DI void tok_info(int t, int& seq_start, int& S) {
  if (t < T_PROMPT) { seq_start = t & ~8191; S = 8192; } else { seq_start = T_PROMPT + ((t - T_PROMPT) & ~16383); S = 16384; }
}
#define CBAR() asm volatile("" ::: "memory")

DI void prep_row(const float* __restrict__ src, bf16_t* __restrict__ dst, float* __restrict__ ss, int lane) {
  const float4* s4 = (const float4*)src;
  float acc = 0.f;
#pragma unroll
  for (int i = 0; i < 4; ++i) {
    const f32x4 v4 = __builtin_nontemporal_load((const f32x4*)s4 + lane + 64 * i);
    float4 v = make_float4(v4[0], v4[1], v4[2], v4[3]);
    acc += v.x * v.x + v.y * v.y + v.z * v.z + v.w * v.w;
    u32x2 o = {pk2(v.x, v.y), pk2(v.z, v.w)};
    *(u32x2*)(dst + (lane + 64 * i) * 4) = o;
  }
#pragma unroll
  for (int s = 32; s >= 1; s >>= 1) acc += __shfl_xor(acc, s);
  if (lane == 0) *ss = acc;
}

DI void transpose_tile(const float* __restrict__ src, int N, const float* __restrict__ scale, bf16_t* __restrict__ dst,
                       int k0, int n0, unsigned char* ldsb, int tid) {
  bf16_t* lds = (bf16_t*)ldsb;
  __syncthreads();
#pragma unroll 4
  for (int j = 0; j < 16; ++j) {
    int k = (tid >> 6) + 4 * j;
    float v = __builtin_nontemporal_load(src + (size_t)(k0 + k) * N + n0 + (tid & 63));
    if (scale) v *= scale[k0 + k];
    lds[(tid & 63) * 66 + k] = f2bf(v);
  }
  __syncthreads();
#pragma unroll
  for (int j = 0; j < 8; ++j) {
    int n = (tid >> 5) + 8 * j;
    unsigned v = *(const unsigned*)&lds[n * 66 + (tid & 31) * 2];
    *(unsigned*)&dst[(size_t)(n0 + n) * 1024 + k0 + (tid & 31) * 2] = v;
  }
}

DI void phase_prep(const Params& p, unsigned char* lds, int vb, int vg, int tid) {
  unsigned char* ws = p.ws;
  bf16_t* XB = (bf16_t*)(ws + OFF_XB);
  float* XSS = (float*)(ws + OFF_XSS);
  bf16_t* MEMB = (bf16_t*)(ws + OFF_MEMB);
  float* MEMSS = (float*)(ws + OFF_MEMSS);
  bf16_t* WIN = (bf16_t*)(ws + OFF_WIN);
  bf16_t* WOUT = (bf16_t*)(ws + OFF_WOUT);
  bf16_t* WKV = (bf16_t*)(ws + OFF_WKV);
  float* LB = (float*)(ws + OFF_LB);
  const int lane = tid & 63, wid = tid >> 6;
  constexpr int N_ROWIT = (T_TOK + 2560) / 4;
  constexpr int N_TR_IN = 4 * 16 * 64, N_TR_OUT = 4 * 16 * 16, N_TR_KV = 4 * 16 * 8;
  constexpr int N_ITEMS = N_ROWIT + N_TR_IN + N_TR_OUT + N_TR_KV;
  for (int it = vb; it < N_ITEMS; it += vg) {
    if (it < N_ROWIT) {
      int row = it * 4 + wid;
      if (row < T_TOK) {
        const float* src = row < T_PROMPT ? p.x_prompt + (size_t)row * 1024 : p.x_sample + (size_t)(row - T_PROMPT) * 1024;
        prep_row(src, XB + (size_t)row * 1024, XSS + row, lane);
      } else {
        int r = row - T_TOK;
        const float* src = r < 2048 ? p.mem_prompt + (size_t)r * 1024 : p.mem_sample + (size_t)(r - 2048) * 1024;
        prep_row(src, MEMB + (size_t)r * 1024, MEMSS + r, lane);
      }
    } else if (it < N_ROWIT + N_TR_IN) {
      int i = it - N_ROWIT; int l = i >> 10, kt = (i >> 6) & 15, nt = i & 63;
      transpose_tile(p.w_in + (size_t)l * 1024 * 4096, 4096, p.norm_w + l * 1024, WIN + (size_t)l * 4096 * 1024, kt * 64, nt * 64, lds, tid);
    } else if (it < N_ROWIT + N_TR_IN + N_TR_OUT) {
      int i = it - N_ROWIT - N_TR_IN; int l = i >> 8, kt = (i >> 4) & 15, nt = i & 15;
      transpose_tile(p.w_out + (size_t)l * 1024 * 1024, 1024, nullptr, WOUT + (size_t)l * 1024 * 1024, kt * 64, nt * 64, lds, tid);
    } else {
      int i = it - N_ROWIT - N_TR_IN - N_TR_OUT; int l = i >> 7, kt = (i >> 3) & 15, nt = i & 7;
      transpose_tile(p.mem_wkv + (size_t)l * 1024 * 512, 512, p.mem_norm_w + l * 1024, WKV + (size_t)l * 512 * 1024, kt * 64, nt * 64, lds, tid);
    }
  }
  if (vb == 0) {
    for (int idx = tid; idx < 1024; idx += 256) {
      int dir = idx >> 9, c = idx & 511;
      const float* src = dir ? p.lb_bwd : p.lb_fwd;
      float v0 = src[c], v1 = src[512 + c], v2 = src[1024 + c], v3 = src[1536 + c];
      float m = fmaxf(fmaxf(v0, v1), fmaxf(v2, v3));
      float e0 = expf(v0 - m), e1 = expf(v1 - m), e2 = expf(v2 - m), e3 = expf(v3 - m);
      float inv = 1.f / (e0 + e1 + e2 + e3);
      float* o = LB + dir * 2048 + c;
      o[0] = 0.f; o[512] = e1 * inv; o[1024] = (e1 + e2) * inv; o[1536] = (e1 + e2 + e3) * inv;
    }
  }
}

DI void gemm_mainloop(const bf16_t* __restrict__ tokp, size_t ldt, const bf16_t* __restrict__ W, int m0, int n0,
                      unsigned char* lds, f32x4 (&acc)[4][8], int tid) {
  const int lane = tid & 63, wid = tid >> 6, wr = wid >> 2, wc = wid & 3;
  const int wid_s = __builtin_amdgcn_readfirstlane(wid);
  unsigned gA0, gB0;
  {
    const int row = tid >> 3, c = (tid & 7) ^ (row & 7);
    gA0 = (unsigned)((size_t)(m0 + row) * ldt + c * 8);
    const int nt = row >> 4, ii = row & 15, nl = 16 * (ii >> 2) + 4 * nt + (ii & 3);
    gB0 = (unsigned)((n0 + nl) * 1024 + c * 8);
  }
  const unsigned ldt64 = (unsigned)(64 * ldt);
#pragma unroll
  for (int a = 0; a < 4; ++a)
#pragma unroll
    for (int b = 0; b < 8; ++b) acc[a][b] = (f32x4){0.f, 0.f, 0.f, 0.f};
  unsigned char* dma = lds + 1024 * wid_s;
#define GLDS_PART(kt_, st_, i) do { \
      __builtin_amdgcn_global_load_lds((const unsigned*)(tokp + (size_t)((i) * ldt64 + (kt_) * 64) + gA0), (LDSAS unsigned*)(dma + (st_) * 32768 + 8192 * (i)), 16, 0, 0); \
      __builtin_amdgcn_global_load_lds((const unsigned*)(W + (size_t)((i) * 65536 + (kt_) * 64) + gB0), (LDSAS unsigned*)(dma + 65536 + (st_) * 32768 + 8192 * (i)), 16, 0, 0); } while (0)
  const int fr = lane & 15, fq = lane >> 4;
  const unsigned char* tb0 = lds + (128 * wr + fr) * 128 + 16 * (fq ^ (fr & 7));
  const unsigned char* tb1 = lds + (128 * wr + fr) * 128 + 16 * ((4 + fq) ^ (fr & 7));
  const unsigned char* wb0 = lds + 65536 + (64 * wc + fr) * 128 + 16 * (fq ^ (fr & 7));
  const unsigned char* wb1 = lds + 65536 + (64 * wc + fr) * 128 + 16 * ((4 + fq) ^ (fr & 7));
#define LD_W(dst, st_, wb_) _Pragma("unroll") for (int nt = 0; nt < 4; ++nt) dst[nt] = *(const bf16x8*)(wb_ + (st_) * 32768 + nt * 2048)
#define LD_T(dst, st_, mh_, tb_) _Pragma("unroll") for (int mt = 0; mt < 4; ++mt) dst[mt] = *(const bf16x8*)(tb_ + (st_) * 32768 + ((mh_) * 4 + mt) * 2048)
#define MMA(wf_, tf_, mh_) do { __builtin_amdgcn_s_setprio(1); _Pragma("unroll") for (int nt = 0; nt < 4; ++nt) _Pragma("unroll") for (int mt = 0; mt < 4; ++mt) \
    acc[nt][(mh_) * 4 + mt] = mfma16(wf_[nt], tf_[mt], acc[nt][(mh_) * 4 + mt]); __builtin_amdgcn_s_setprio(0); } while (0)
#define SB() __builtin_amdgcn_sched_barrier(0)
  asm volatile("s_waitcnt lgkmcnt(0)" ::: "memory");
  __builtin_amdgcn_s_barrier();
  GLDS_PART(0, 0, 0); GLDS_PART(0, 0, 1); GLDS_PART(0, 0, 2); GLDS_PART(0, 0, 3);
  asm volatile("s_waitcnt vmcnt(0)" ::: "memory");
  __builtin_amdgcn_s_barrier();
  GLDS_PART(1, 1, 0);
  bf16x8 wf0[4], wf1[4], tfA[4], tfB[4];
  LD_W(wf0, 0, wb0); LD_T(tfA, 0, 0, tb0);
  SB();
#define KTILE(cs, ns, k1, k2) do { \
    LD_T(tfB, cs, 1, tb0); GLDS_PART(k1, ns, 1); GLDS_PART(k1, ns, 2);   SB(); \
    MMA(wf0, tfA, 0);                               SB(); \
    LD_W(wf1, cs, wb1); LD_T(tfA, cs, 0, tb1); GLDS_PART(k1, ns, 3);     SB(); \
    MMA(wf0, tfB, 1);                               SB(); \
    LD_T(tfB, cs, 1, tb1);                          SB(); \
    MMA(wf1, tfA, 0);                               SB(); \
    asm volatile("s_waitcnt vmcnt(0) lgkmcnt(0)" ::: "memory"); \
    __builtin_amdgcn_s_barrier();                   SB(); \
    GLDS_PART(k2, cs, 0); LD_W(wf0, ns, wb0); LD_T(tfA, ns, 0, tb0);     SB(); \
    MMA(wf1, tfB, 1);                               SB(); } while (0)
  for (int kp = 0; kp < 8; ++kp) {
    const int ka = 2 * kp + 1, kb = 2 * kp + 2 < 16 ? 2 * kp + 2 : 15, kc = 2 * kp + 3 < 16 ? 2 * kp + 3 : 15;
    KTILE(0, 1, ka, kb);
    KTILE(1, 0, kb, kc);
  }
#undef KTILE
#undef GLDS_PART
#undef LD_W
#undef LD_T
#undef MMA
#undef SB
}

DI void epi_z(const f32x4 (&acc)[4][8], bf16_t* __restrict__ dst, int ldd, const float* __restrict__ ss, int m0, int n0, int tid, int act = 0) {
  asm volatile("" : "+v"(tid));
  const int lane = tid & 63, wid = tid >> 6, wr = wid >> 2, wc = wid & 3, fr = lane & 15, g = lane >> 4;
  const int nw0 = n0 + 64 * wc;
#pragma unroll
  for (int mt = 0; mt < 8; ++mt) {
    const int tok = m0 + 128 * wr + 16 * mt + fr;
    const float rs = rsqrtf(ss[tok] * (1.f / 1024.f) + EPS);
    float v[16];
#pragma unroll
    for (int nt = 0; nt < 4; ++nt)
#pragma unroll
      for (int r = 0; r < 4; ++r) v[4 * nt + r] = acc[nt][mt][r] * rs;
    if (act == 1) {
#pragma unroll
      for (int j = 0; j < 16; ++j) v[j] = v[j] * frcp(1.f + fexp(-v[j]));
    } else if (act == 2) {
#pragma unroll
      for (int j = 0; j < 16; ++j) v[j] = frcp(1.f + fexp(v[j]));
    }
    u32x4 o0 = {pk2(v[0], v[1]), pk2(v[2], v[3]), pk2(v[4], v[5]), pk2(v[6], v[7])};
    u32x4 o1 = {pk2(v[8], v[9]), pk2(v[10], v[11]), pk2(v[12], v[13]), pk2(v[14], v[15])};
    bf16_t* d = dst + (size_t)tok * ldd + nw0 + 16 * g;
    __builtin_nontemporal_store(o0, (u32x4*)d); __builtin_nontemporal_store(o1, (u32x4*)(d + 8));
  }
}

DI void norm_fixup(bf16_t* __restrict__ dst, int ldd, int m0, int n0, const float* __restrict__ normw, float post, bool rope, int tid) {
  asm volatile("" : "+v"(tid));
  asm volatile("s_waitcnt vmcnt(0)" ::: "memory");
  __syncthreads();
#pragma unroll 1
  for (int i = 0; i < 2; ++i) {
    const int row = tid + 512 * i; const int head = row & 3, tok = m0 + (row >> 2);
    bf16_t* d = dst + (size_t)tok * ldd + n0 + head * 64;
    u32x4 raw[8];
#pragma unroll
    for (int j = 0; j < 8; ++j) raw[j] = *(const u32x4*)(d + 8 * j);
    float s = 0.f;
#pragma unroll
    for (int j = 0; j < 8; ++j)
#pragma unroll
      for (int e = 0; e < 4; ++e) { const float a = bflo(raw[j][e]), b = bfhi(raw[j][e]); s += a * a + b * b; }
    const float hr = rsqrtf(s * (1.f / 64.f) + EPS);
    float c8[8], s8[8];
    if (rope) {
      int ss0, S; tok_info(tok, ss0, S);
      const float pos = (float)(tok - ss0);
      const float ifh[8] = {0.1591796875f, 0.030853271484375f, 0.0059814453125f, 0.0011615753173828125f,
                            0.000225067138671875f, 4.363059997558594e-05f, 8.463859558105469e-06f, 1.6409903764724731e-06f};
      const float ifl[8] = {-2.474440771038644e-05f, 1.0491919965716079e-05f, 3.7404001886898186e-06f, -9.116761248151306e-07f,
                            1.1940367805607366e-08f, 1.7352817849314306e-08f, 4.712501500137023e-10f, 4.3588632703261965e-10f};
#pragma unroll
      for (int q = 0; q < 8; ++q) {
        const float ph = pos * ifh[q];
        const float fr_ = (ph - floorf(ph)) + pos * ifl[q];
        s8[q] = __builtin_amdgcn_sinf(fr_); c8[q] = __builtin_amdgcn_cosf(fr_);
      }
    }
#pragma unroll
    for (int j = 0; j < 8; ++j) {
      float v[8];
#pragma unroll
      for (int e = 0; e < 4; ++e) {
        v[2 * e] = bflo(raw[j][e]) * hr * normw[8 * j + 2 * e];
        v[2 * e + 1] = bfhi(raw[j][e]) * hr * normw[8 * j + 2 * e + 1];
      }
      if (rope && j < 2) {
#pragma unroll
        for (int e = 0; e < 4; ++e) {
          const float o0 = bflo(raw[1 - j][e]) * hr * normw[8 * (1 - j) + 2 * e], o1 = bfhi(raw[1 - j][e]) * hr * normw[8 * (1 - j) + 2 * e + 1];
          if (j == 0) { v[2 * e] = v[2 * e] * c8[2 * e] - o0 * s8[2 * e]; v[2 * e + 1] = v[2 * e + 1] * c8[2 * e + 1] - o1 * s8[2 * e + 1]; }
          else { v[2 * e] = v[2 * e] * c8[2 * e] + o0 * s8[2 * e]; v[2 * e + 1] = v[2 * e + 1] * c8[2 * e + 1] + o1 * s8[2 * e + 1]; }
        }
      }
      u32x4 o = {pk2(v[0] * post, v[1] * post), pk2(v[2] * post, v[3] * post), pk2(v[4] * post, v[5] * post), pk2(v[6] * post, v[7] * post)};
      *(u32x4*)(d + 8 * j) = o;
    }
  }
}

DI void epi_out(const f32x4 (&acc)[4][8], const Params& p, int layer, int m0, int n0, int tid) {
  asm volatile("" : "+v"(tid));
  const int lane = tid & 63, wid = tid >> 6, wr = wid >> 2, wc = wid & 3, fr = lane & 15, g = lane >> 4;
  bf16_t* XB = (bf16_t*)(p.ws + OFF_XB);
  float* XSS = (float*)(p.ws + OFF_XSS);
  const int nb = n0 + 64 * wc + 16 * g;
#pragma unroll
  for (int mt = 0; mt < 8; ++mt) {
    const int tok = m0 + 128 * wr + 16 * mt + fr;
    bf16_t* d = XB + (size_t)tok * 1024 + nb;
    float v[16];
    {
      const u32x4 x0 = *(const u32x4*)d, x1 = *(const u32x4*)(d + 8);
#pragma unroll
      for (int nt = 0; nt < 2; ++nt) {
        v[4 * nt + 0] = bflo(x0[2 * nt]) + acc[nt][mt][0]; v[4 * nt + 1] = bfhi(x0[2 * nt]) + acc[nt][mt][1];
        v[4 * nt + 2] = bflo(x0[2 * nt + 1]) + acc[nt][mt][2]; v[4 * nt + 3] = bfhi(x0[2 * nt + 1]) + acc[nt][mt][3];
        v[8 + 4 * nt + 0] = bflo(x1[2 * nt]) + acc[2 + nt][mt][0]; v[8 + 4 * nt + 1] = bfhi(x1[2 * nt]) + acc[2 + nt][mt][1];
        v[8 + 4 * nt + 2] = bflo(x1[2 * nt + 1]) + acc[2 + nt][mt][2]; v[8 + 4 * nt + 3] = bfhi(x1[2 * nt + 1]) + acc[2 + nt][mt][3];
      }
    }
    if (layer == 3) {
      float* od = p.out + (size_t)tok * 1024 + nb;
#pragma unroll
      for (int nt = 0; nt < 4; ++nt) *(float4*)(od + 4 * nt) = make_float4(v[4 * nt], v[4 * nt + 1], v[4 * nt + 2], v[4 * nt + 3]);
    } else {
      float s = 0.f;
#pragma unroll
      for (int j = 0; j < 16; ++j) s += v[j] * v[j];
      u32x4 o0 = {pk2(v[0], v[1]), pk2(v[2], v[3]), pk2(v[4], v[5]), pk2(v[6], v[7])};
      u32x4 o1 = {pk2(v[8], v[9]), pk2(v[10], v[11]), pk2(v[12], v[13]), pk2(v[14], v[15])};
      *(u32x4*)d = o0; *(u32x4*)(d + 8) = o1;
      s += __shfl_xor(s, 16); s += __shfl_xor(s, 32);
      if (g == 0) atomicAdd(XSS + tok, s);
    }
  }
}

DI void phase_inproj(const Params& p, int layer, unsigned char* lds, int tid) {
  unsigned char* ws = p.ws;
  bf16_t* Z = (bf16_t*)(ws + OFF_Z);
  const bf16_t* XB = (const bf16_t*)(ws + OFF_XB);
  const float* XSS = (const float*)(ws + OFF_XSS);
  const bf16_t* WIN = (const bf16_t*)(ws + OFF_WIN) + (size_t)layer * 4096 * 1024;
  constexpr int NT_IN = (T_TOK / 256) * 16;
  const int n_extra = layer == 0 ? 4 * 10 * 2 : 0;
  for (int it = blockIdx.x; it < NT_IN + n_extra; it += gridDim.x) {
    f32x4 acc[4][8];
    if (it < NT_IN) {
      int mt_ = it >> 4, nt_ = it & 15;
      if (gridDim.x == 256) {
        const int r = it >> 8, x = blockIdx.x & 7, j = blockIdx.x >> 3;
        mt_ = r * 16 + (x >> 2) * 8 + (j >> 2);
        nt_ = 4 * (((x & 3) + r / 6) & 3) + (j & 3);
      }
      const int m0 = mt_ * 256, n0 = nt_ * 256;
      gemm_mainloop(XB, 1024, WIN, m0, n0, lds, acc, tid);
      epi_z(acc, Z, NIN, XSS, m0, n0, tid, (n0 < C_FF || n0 >= C_GH) ? 1 : (n0 < C_HI ? 2 : 0));
      if (n0 == C_AQ) norm_fixup(Z, NIN, m0, n0, p.aq_w + layer * 64, 0.125f * 1.4426950408889634f, true, tid);
      else if (n0 == C_AK) norm_fixup(Z, NIN, m0, n0, p.ak_w + layer * 64, 1.f, true, tid);
      else if (n0 == C_MQ) norm_fixup(Z, NIN, m0, n0, p.mq_w + layer * 64, 0.125f * 1.4426950408889634f, false, tid);
    } else {
      const int i = it - NT_IN; const int l = i / 20, r = i % 20, mt_ = r >> 1, nt_ = r & 1, m0 = mt_ * 256, n0 = nt_ * 256;
      const bf16_t* MEMB = (const bf16_t*)(ws + OFF_MEMB);
      const float* MEMSS = (const float*)(ws + OFF_MEMSS);
      const bf16_t* WKV = (const bf16_t*)(ws + OFF_WKV) + (size_t)l * 512 * 1024;
      bf16_t* MKV = (bf16_t*)(ws + OFF_MKV) + (size_t)l * 2560 * 512;
      gemm_mainloop(MEMB, 1024, WKV, m0, n0, lds, acc, tid);
      epi_z(acc, MKV, 512, MEMSS, m0, n0, tid);
      if (n0 == 0) norm_fixup(MKV, 512, m0, n0, p.mk_w + l * 64, 1.f, false, tid);
    }
  }
}

DI void phase_outproj(const Params& p, int layer, unsigned char* lds, int tid) {
  unsigned char* ws = p.ws;
  const bf16_t* Zm = (const bf16_t*)(ws + OFF_Z) + C_GH;
  const bf16_t* WOUT = (const bf16_t*)(ws + OFF_WOUT) + (size_t)layer * 1024 * 1024;
  constexpr int NT_OUT = (T_TOK / 256) * 4;
  for (int it = blockIdx.x; it < NT_OUT; it += gridDim.x) {
    f32x4 acc[4][8];
    int mt_ = it >> 2, nt_ = it & 3;
    if (gridDim.x == 256) {
      const int r = it >> 8, x = blockIdx.x & 7, j = blockIdx.x >> 3;
      mt_ = r * 64 + x * 8 + (j >> 2); nt_ = j & 3;
    }
    const int m0 = mt_ * 256, n0 = nt_ * 256;
    gemm_mainloop(Zm, NIN, WOUT, m0, n0, lds, acc, tid);
    epi_out(acc, p, layer, m0, n0, tid);
  }
}

constexpr int L_QI = 0, L_KE = 17408, L_V = 34816, L_P = 52224, L_TOT = 61440, L_DEC = 63488;
constexpr int RS = 272;
constexpr int PS = 144;

constexpr int SEG_CH = 8;
constexpr int N_SEG = T_TOK / (64 * SEG_CH);
constexpr int N_UNITS = N_SEG * 8;

template <bool FULL>
DI void scan_unit(const Params& p, int layer, int unit, unsigned char* lds, int tid) {
  unsigned char* ws = p.ws;
  bf16_t* Z = (bf16_t*)(ws + OFF_Z);
  float* H = p.out + (size_t)unit * 16384;
  float* DS = p.out + (size_t)N_UNITS * 16384 + unit * 128;
  const float* LB = (const float*)(ws + OFF_LB);
  const int seg = unit >> 3, head = (unit >> 1) & 3, dir = unit & 1;
  const int lane = tid & 63, w = tid >> 6;
  const int r = lane & 31, h = lane >> 5, i16 = lane & 15, gg = (lane >> 4) & 1, q4 = i16 >> 2, p4 = i16 & 3;
  const int cq = tid & 31, tg = tid >> 5;
  const int fcol = (dir ? C_FB : C_FF) + head * 128;
  const f32x4 lbv = *(const f32x4*)(LB + (dir * 4 + layer) * 512 + head * 128 + 4 * cq);
  const f32x4 om = (f32x4){1.f, 1.f, 1.f, 1.f} - lbv;
  float one = 1.f; asm volatile("" : "+v"(one));
  f32x4 dprod = {one, one, one, one};

  f32x16 st[4];
  if (FULL) {
#pragma unroll
    for (int kb = 0; kb < 4; ++kb)
#pragma unroll
      for (int reg = 0; reg < 16; ++reg) st[kb][reg] = H[(32 * kb + crow(reg, h)) * 128 + 32 * w + r];
  } else {
#pragma unroll
    for (int kb = 0; kb < 4; ++kb)
#pragma unroll
      for (int reg = 0; reg < 16; ++reg) st[kb][reg] = 0.f;
  }
  const int srow = tid >> 4, sch = tid & 15;
  u32x4 pf_f[4], pf_v[4], pf_q[4];
  {
    const int c0 = seg * (64 * SEG_CH) + (dir ? SEG_CH - 1 : 0) * 64;
#pragma unroll
    for (int j = 0; j < 4; ++j) {
      const int i = srow + 16 * j; const bf16_t* zr = Z + (size_t)(c0 + (dir ? 63 - i : i)) * NIN + 8 * sch;
      pf_f[j] = *(const u32x4*)(zr + fcol); pf_v[j] = *(const u32x4*)(zr + C_HI + head * 128);
      if (FULL) pf_q[j] = *(const u32x4*)(zr + C_HQ + head * 128);
    }
  }

  for (int cc = 0; cc < SEG_CH; ++cc) {
    const int c0 = seg * (64 * SEG_CH) + (dir ? SEG_CH - 1 - cc : cc) * 64;
    __syncthreads();
#pragma unroll
    for (int j = 0; j < 4; ++j) {
      const int i = srow + 16 * j;
      *(u32x4*)(lds + L_KE + i * RS + 16 * sch) = pf_f[j];
      *(u32x4*)(lds + L_V + i * RS + 16 * sch) = pf_v[j];
      if (FULL) *(u32x4*)(lds + L_QI + i * RS + 16 * sch) = pf_q[j];
    }
    __syncthreads();
    if (cc + 1 < SEG_CH) {
      const int c1 = seg * (64 * SEG_CH) + (dir ? SEG_CH - 2 - cc : cc + 1) * 64;
#pragma unroll
      for (int j = 0; j < 4; ++j) {
        const int i = srow + 16 * j; const bf16_t* zr = Z + (size_t)(c1 + (dir ? 63 - i : i)) * NIN + 8 * sch;
        pf_f[j] = *(const u32x4*)(zr + fcol); pf_v[j] = *(const u32x4*)(zr + C_HI + head * 128);
        if (FULL) pf_q[j] = *(const u32x4*)(zr + C_HQ + head * 128);
      }
    }
    {
      f32x4 t = {one, one, one, one};
#pragma unroll
      for (int ii = 0; ii < 8; ++ii) {
        const u32x2 zz = *(const u32x2*)(lds + L_KE + (8 * tg + ii) * RS + 8 * cq);
        t[0] *= 1.f - om[0] * bflo(zz[0]); t[1] *= 1.f - om[1] * bfhi(zz[0]);
        t[2] *= 1.f - om[2] * bflo(zz[1]); t[3] *= 1.f - om[3] * bfhi(zz[1]);
      }
      *(f32x4*)(lds + L_P + (tg * 128 + 4 * cq) * 4) = t;
    }
    __syncthreads();
    {
      f32x4 eb = {one, one, one, one}, bl = {one, one, one, one};
#pragma unroll
      for (int qq = 0; qq < 8; ++qq) {
        const f32x4 tt = *(const f32x4*)(lds + L_P + (qq * 128 + 4 * cq) * 4);
        if (qq < tg) eb = eb * tt;
        bl = bl * tt;
      }
      if (tg == 0) { *(f32x4*)(lds + L_DEC + 4 * cq * 4) = bl; dprod = dprod * bl; }
#pragma unroll
      for (int ii = 0; ii < 8; ++ii) {
        const int i = 8 * tg + ii;
        const u32x2 zz = *(const u32x2*)(lds + L_KE + i * RS + 8 * cq);
        f32x4 k = {om[0] * bflo(zz[0]), om[1] * bfhi(zz[0]), om[2] * bflo(zz[1]), om[3] * bfhi(zz[1])};
        eb = eb * ((f32x4){1.f, 1.f, 1.f, 1.f} - k);
        f32x4 ke = {k[0] * frcp(fmaxf(eb[0], 1e-30f)), k[1] * frcp(fmaxf(eb[1], 1e-30f)), k[2] * frcp(fmaxf(eb[2], 1e-30f)), k[3] * frcp(fmaxf(eb[3], 1e-30f))};
        *(u32x2*)(lds + L_KE + i * RS + 8 * cq) = (u32x2){pk2(ke[0], ke[1]), pk2(ke[2], ke[3])};
        if (FULL) {
          const u32x2 zq = *(const u32x2*)(lds + L_QI + i * RS + 8 * cq);
          *(u32x2*)(lds + L_QI + i * RS + 8 * cq) = (u32x2){pk2(bflo(zq[0]) * eb[0], bfhi(zq[0]) * eb[1]), pk2(bflo(zq[1]) * eb[2], bfhi(zq[1]) * eb[3])};
        }
      }
    }
    __syncthreads();
    bf16x8 bv[4];
#pragma unroll
    for (int s = 0; s < 4; ++s) {
      const unsigned char* a = lds + L_V + (16 * s + 8 * h + q4) * RS + (32 * w + 16 * gg + 4 * p4) * 2;
      bv[s] = cat4(trread(a), trread(a + 4 * RS));
    }
    if (FULL) {
      if (w < 3) {
        const int tb = w == 0 ? 0 : 1, sb = w == 2 ? 1 : 0;
        f32x16 sc;
#pragma unroll
        for (int reg = 0; reg < 16; ++reg) sc[reg] = 0.f;
#pragma unroll
        for (int s = 0; s < 8; ++s) {
          bf16x8 a = *(const bf16x8*)(lds + L_QI + (32 * tb + r) * RS + (16 * s + 8 * h) * 2);
          bf16x8 b = *(const bf16x8*)(lds + L_KE + (32 * sb + r) * RS + (16 * s + 8 * h) * 2);
          sc = mfma32(b, a, sc);
        }
        const int t = 32 * tb + r;
#pragma unroll
        for (int rq = 0; rq < 4; ++rq) {
          const int s0 = 32 * sb + 8 * rq + 4 * h;
          float v0 = s0 <= t ? sc[4 * rq] : 0.f, v1 = s0 + 1 <= t ? sc[4 * rq + 1] : 0.f, v2 = s0 + 2 <= t ? sc[4 * rq + 2] : 0.f, v3 = s0 + 3 <= t ? sc[4 * rq + 3] : 0.f;
          *(u32x2*)(lds + L_P + t * PS + s0 * 2) = (u32x2){pk2(v0, v1), pk2(v2, v3)};
        }
      }
      __syncthreads();
#pragma unroll
      for (int tb = 0; tb < 2; ++tb) {
        f32x16 o;
#pragma unroll
        for (int reg = 0; reg < 16; ++reg) o[reg] = 0.f;
#pragma unroll
        for (int kb = 0; kb < 4; ++kb)
#pragma unroll
          for (int s2 = 0; s2 < 2; ++s2) {
            u32x4 pb = {pk2(st[kb][8 * s2 + 0], st[kb][8 * s2 + 1]), pk2(st[kb][8 * s2 + 2], st[kb][8 * s2 + 3]),
                        pk2(st[kb][8 * s2 + 4], st[kb][8 * s2 + 5]), pk2(st[kb][8 * s2 + 6], st[kb][8 * s2 + 7])};
            bf16x8 bst = __builtin_bit_cast(bf16x8, pb);
            const unsigned char* a = lds + L_QI + (32 * tb + r) * RS + (32 * kb + 16 * s2 + 4 * h) * 2;
            s16x4 lo = *(const s16x4*)a, hi = *(const s16x4*)(a + 16);
            o = mfma32(bst, cat4(lo, hi), o);
            if (s2 == 1 && (kb & 1)) __builtin_amdgcn_sched_barrier(0);
          }
#pragma unroll
        for (int s = 0; s < 4; ++s) {
          if (tb == 0 && s >= 2) continue;
          bf16x8 a = *(const bf16x8*)(lds + L_P + (32 * tb + r) * PS + (16 * s + 8 * h) * 2);
          o = mfma32(bv[s], a, o);
        }
#pragma unroll
        for (int rq = 0; rq < 4; ++rq) {
          *(u32x2*)(lds + L_V + (32 * tb + r) * RS + (32 * w + 8 * rq + 4 * h) * 2) = (u32x2){pk2(o[4 * rq], o[4 * rq + 1]), pk2(o[4 * rq + 2], o[4 * rq + 3])};
        }
        __builtin_amdgcn_sched_barrier(0);
      }
      __syncthreads();
#pragma unroll
      for (int j = 0; j < 4; ++j) {
        const int i = srow + 16 * j; const int tok = c0 + (dir ? 63 - i : i);
        *(u32x4*)(Z + (size_t)tok * NIN + fcol + 8 * sch) = *(const u32x4*)(lds + L_V + i * RS + 16 * sch);
      }
    }
#pragma unroll
    for (int kb = 0; kb < 4; ++kb) {
#pragma unroll
      for (int s = 0; s < 4; ++s) {
        const unsigned char* a = lds + L_KE + (16 * s + 8 * h + q4) * RS + (32 * kb + 16 * gg + 4 * p4) * 2;
        bf16x8 af = cat4(trread(a), trread(a + 4 * RS));
        st[kb] = mfma32(af, bv[s], st[kb]);
      }
#pragma unroll
      for (int rq = 0; rq < 4; ++rq) {
        f32x4 d = *(const f32x4*)(lds + L_DEC + (32 * kb + 8 * rq + 4 * h) * 4);
        st[kb][4 * rq + 0] *= d[0]; st[kb][4 * rq + 1] *= d[1]; st[kb][4 * rq + 2] *= d[2]; st[kb][4 * rq + 3] *= d[3];
      }
      __builtin_amdgcn_sched_barrier(0);
    }
  }
  if (!FULL) {
#pragma unroll
    for (int kb = 0; kb < 4; ++kb)
#pragma unroll
      for (int reg = 0; reg < 16; ++reg) H[(32 * kb + crow(reg, h)) * 128 + 32 * w + r] = st[kb][reg];
    if (tg == 0) *(f32x4*)(DS + 4 * cq) = dprod;
  }
}

DI void phase_carry(const Params& p, int vb, int vg, int tid) {
  unsigned char* ws = p.ws;
  float* H = p.out;
  const float* DS = p.out + (size_t)N_UNITS * 16384;
  constexpr int SPP = 8192 / (64 * SEG_CH), SPS = 16384 / (64 * SEG_CH);
  for (int it = vb; it < 80 * 16; it += vg) {
    const int sc = it >> 4, sl = it & 15;
    const int seqi = sc >> 3, head = (sc >> 1) & 3, dir = sc & 1;
    const int seg0 = seqi < 8 ? SPP * seqi : 8 * SPP + SPS * (seqi - 8), nseg = seqi < 8 ? SPP : SPS;
    const int e = 1024 * sl + 4 * tid, k = e >> 7;
    f32x4 carry = {0.f, 0.f, 0.f, 0.f};
    for (int j0 = 0; j0 < nseg; j0 += 8) {
      f32x4 ev[8]; float dv[8];
#pragma unroll
      for (int q = 0; q < 8; ++q) {
        const int jj = j0 + q; const int seg = dir ? seg0 + nseg - 1 - jj : seg0 + jj;
        const int unit = seg * 8 + head * 2 + dir;
        ev[q] = *(const f32x4*)(H + (size_t)unit * 16384 + e);
        dv[q] = DS[unit * 128 + k];
      }
#pragma unroll
      for (int q = 0; q < 8; ++q) {
        const int jj = j0 + q; const int seg = dir ? seg0 + nseg - 1 - jj : seg0 + jj;
        const int unit = seg * 8 + head * 2 + dir;
        *(f32x4*)(H + (size_t)unit * 16384 + e) = carry;
        carry = carry * dv[q] + ev[q];
      }
    }
  }
}

DI void softmax_step(const f32x4& sa, const f32x4& sb, float& m_run, float& l_run, f32x4 (&O)[4], bf16x8& pf) {
  float mx = fmaxf(fmaxf(fmaxf(sa[0], sa[1]), fmaxf(sa[2], sa[3])), fmaxf(fmaxf(sb[0], sb[1]), fmaxf(sb[2], sb[3])));
  if (__builtin_amdgcn_ballot_w64(mx > m_run + 8.f) != 0ull) {
    mx = fmaxf(mx, __shfl_xor(mx, 16)); mx = fmaxf(mx, __shfl_xor(mx, 32));
    const float m_new = fmaxf(m_run, mx);
    const float alpha = __builtin_amdgcn_exp2f(m_run - m_new);
    m_run = m_new;
    l_run *= alpha;
#pragma unroll
    for (int dt = 0; dt < 4; ++dt) O[dt] = O[dt] * alpha;
  }
  float pa[4], pb[4], ps = 0.f;
#pragma unroll
  for (int reg = 0; reg < 4; ++reg) {
    pa[reg] = __builtin_amdgcn_exp2f(sa[reg] - m_run);
    pb[reg] = __builtin_amdgcn_exp2f(sb[reg] - m_run);
    ps += pa[reg] + pb[reg];
  }
  l_run += ps;
  u32x4 pp = {pk2(pa[0], pa[1]), pk2(pa[2], pa[3]), pk2(pb[0], pb[1]), pk2(pb[2], pb[3])};
  pf = __builtin_bit_cast(bf16x8, pp);
}

DI void attn_finish(bf16_t* op, float l_run, const f32x4 (&O)[4]) {
  float lt = l_run; lt += __shfl_xor(lt, 16); lt += __shfl_xor(lt, 32);
  const float inv = 1.f / lt;
#pragma unroll
  for (int dt = 0; dt < 4; ++dt) {
    u32x2 gv = *(const u32x2*)(op + 16 * dt);
    float g0 = bflo(gv[0]), g1 = bfhi(gv[0]), g2 = bflo(gv[1]), g3 = bfhi(gv[1]);
    u32x2 o = {pk2(O[dt][0] * inv * g0, O[dt][1] * inv * g1), pk2(O[dt][2] * inv * g2, O[dt][3] * inv * g3)};
    *(u32x2*)(op + 16 * dt) = o;
  }
}

DI void attn_dilated(const Params& p, int gidx, unsigned char* wl, int lane) {
  bf16_t* Z = (bf16_t*)(p.ws + OFF_Z);
  const int u = lane & 15, g = lane >> 4, q4 = u >> 2, p4 = u & 3;
  const int off = gidx & 15, head = (gidx >> 4) & 3, t0 = (gidx >> 6) * 256;
  int seq_start, S; tok_info(t0, seq_start, S);
  const int pos0 = t0 - seq_start + off, qtok = seq_start + pos0 + 16 * u;
  const bf16_t* kbase = Z + (size_t)seq_start * NIN + C_AK + head * 64 + 8 * g;
  const bf16_t* vbase = Z + (size_t)seq_start * NIN + C_AV + head * 64 + 8 * (lane & 7);
  const bf16_t* qp = Z + (size_t)qtok * NIN + C_AQ + head * 64 + 8 * g;
  const bf16x8 qf0 = *(const bf16x8*)qp, qf1 = *(const bf16x8*)(qp + 32);
  float m_run = -1e4f, l_run = 0.f;
  f32x4 O[4];
#pragma unroll
  for (int dt = 0; dt < 4; ++dt) O[dt] = (f32x4){0.f, 0.f, 0.f, 0.f};
  auto step_params = [&](int s, int& stride, int& fk) {
    if (s < 5) { stride = 16; fk = pos0 - 1024 + 512 * s; }
    else if (s < 11) { stride = 4; fk = pos0 - 256 + 128 * (s - 5); }
    else { stride = 1; fk = pos0 - 64 + 32 * (s - 11); }
  };
  auto pat_range = [&](int stride, int c, int& jlo, int& span) {
    const int t = 64 * stride - pos0;
    const int jmin = t <= 0 ? 0 : (t + stride - 1) / stride;
    const int jmax = (S + 64 * stride - pos0 - 1) / stride;
    jlo = max(c * u, jmin); span = min(c * u + 128, jmax) - jlo;
  };
  int jlo3, sp3, jlo2, sp2, jlo1, sp1;
  pat_range(16, 1, jlo3, sp3); pat_range(4, 4, jlo2, sp2); pat_range(1, 16, jlo1, sp1);
  auto load_step = [&](int s, bf16x8 (&kf_)[4], u32x4 (&vv_)[4]) {
    int stride, fk; step_params(s, stride, fk);
    const int kca = min(max(fk + stride * u, 0), S - 1), kcb = min(max(fk + stride * (u + 16), 0), S - 1);
    const bf16_t* ka = kbase + (size_t)kca * NIN; const bf16_t* kb = kbase + (size_t)kcb * NIN;
    kf_[0] = *(const bf16x8*)ka; kf_[1] = *(const bf16x8*)(ka + 32); kf_[2] = *(const bf16x8*)kb; kf_[3] = *(const bf16x8*)(kb + 32);
#pragma unroll
    for (int j = 0; j < 4; ++j) {
      const int kv = min(max(fk + stride * ((lane >> 3) + 8 * j), 0), S - 1);
      vv_[j] = *(const u32x4*)(vbase + (size_t)kv * NIN);
    }
  };
  auto compute_step = [&](int s, const bf16x8 (&kf_)[4], const u32x4 (&vv_)[4]) {
    f32x4 sa = {0.f, 0.f, 0.f, 0.f}, sb = {0.f, 0.f, 0.f, 0.f};
    sa = mfma16(kf_[0], qf0, sa); sa = mfma16(kf_[1], qf1, sa);
    sb = mfma16(kf_[2], qf0, sb); sb = mfma16(kf_[3], qf1, sb);
    CBAR();
#pragma unroll
    for (int j = 0; j < 4; ++j) *(u32x4*)(wl + ((lane >> 3) + 8 * j) * 144 + 16 * (lane & 7)) = vv_[j];
    CBAR();
    int jb, span;
    if (s < 5) { jb = 32 * s + 4 * g - jlo3; span = sp3; }
    else if (s < 11) { jb = 32 * (s - 5) + 4 * g - jlo2; span = sp2; }
    else { jb = 32 * (s - 11) + 4 * g - jlo1; span = sp1; }
#pragma unroll
    for (int reg = 0; reg < 4; ++reg) {
      sa[reg] = (unsigned)(jb + reg) <= (unsigned)span ? sa[reg] : -1e30f;
      sb[reg] = (unsigned)(jb + reg + 16) <= (unsigned)span ? sb[reg] : -1e30f;
    }
    bf16x8 pf;
    softmax_step(sa, sb, m_run, l_run, O, pf);
#pragma unroll
    for (int dt = 0; dt < 4; ++dt) {
      const unsigned char* a = wl + (4 * g + q4) * 144 + (16 * dt + 4 * p4) * 2;
      bf16x8 vf = cat4(trread(a), trread(a + 16 * 144));
      O[dt] = mfma16(vf, pf, O[dt]);
    }
    CBAR();
  };
  bf16x8 kfA[4], kfB[4]; u32x4 vvA[4], vvB[4];
  load_step(0, kfA, vvA);
  for (int s = 0; s < 22; s += 2) {
    load_step(s + 1, kfB, vvB);
    compute_step(s, kfA, vvA);
    load_step(s + 2, kfA, vvA);
    compute_step(s + 1, kfB, vvB);
  }
  compute_step(22, kfA, vvA);
  attn_finish(Z + (size_t)qtok * NIN + C_GA + head * 64 + 4 * g, l_run, O);
}

constexpr int L_MK = 0, L_MV = 32768;
DI void attn_mem_item(const Params& p, int layer, int item, unsigned char* lds, int tid) {
  bf16_t* Z = (bf16_t*)(p.ws + OFF_Z);
  const int lane = tid & 63, wid = tid >> 6;
  const int u = lane & 15, g = lane >> 4, q4 = u >> 2, p4 = u & 3;
  const int head = item & 3, t0 = (item >> 2) * 256;
  const int b = t0 < T_PROMPT ? (t0 >> 13) : 8 + ((t0 - T_PROMPT) >> 14);
  const bf16_t* MKV = (const bf16_t*)(p.ws + OFF_MKV) + ((size_t)layer * 2560 + b * 256) * 512 + head * 64;
  __syncthreads();
#pragma unroll
  for (int j = 0; j < 8; ++j) {
    const int q = tid + 256 * j; const int row = q >> 3, c = q & 7;
    u32x4 kv = *(const u32x4*)(MKV + (size_t)row * 512 + 8 * c);
    u32x4 vv = *(const u32x4*)(MKV + (size_t)row * 512 + 256 + 8 * c);
    *(u32x4*)(lds + L_MK + row * 128 + 16 * (c ^ (row & 7))) = kv;
    *(u32x4*)(lds + L_MV + row * 128 + 16 * ((((c >> 1) ^ ((row >> 1) & 3)) << 1) | (c & 1))) = vv;
  }
  __syncthreads();
  for (int gp = 0; gp < 2; ++gp) {
    int qtok[2]; bf16x8 qf0[2], qf1[2]; float m_run[2], l_run[2]; f32x4 O[2][4];
#pragma unroll
    for (int e = 0; e < 2; ++e) {
      qtok[e] = t0 + (wid * 4 + gp * 2 + e) * 16 + u;
      const bf16_t* qp = Z + (size_t)qtok[e] * NIN + C_MQ + head * 64 + 8 * g;
      qf0[e] = *(const bf16x8*)qp; qf1[e] = *(const bf16x8*)(qp + 32);
      m_run[e] = -1e4f; l_run[e] = 0.f;
#pragma unroll
      for (int dt = 0; dt < 4; ++dt) O[e][dt] = (f32x4){0.f, 0.f, 0.f, 0.f};
    }
#pragma unroll 2
    for (int s = 0; s < 8; ++s) {
      const int ra = 32 * s + u, rb = ra + 16;
      const bf16x8 ka0 = *(const bf16x8*)(lds + L_MK + ra * 128 + 16 * (g ^ (ra & 7)));
      const bf16x8 ka1 = *(const bf16x8*)(lds + L_MK + ra * 128 + 16 * ((4 + g) ^ (ra & 7)));
      const bf16x8 kb0 = *(const bf16x8*)(lds + L_MK + rb * 128 + 16 * (g ^ (rb & 7)));
      const bf16x8 kb1 = *(const bf16x8*)(lds + L_MK + rb * 128 + 16 * ((4 + g) ^ (rb & 7)));
      bf16x8 pf[2];
#pragma unroll
      for (int e = 0; e < 2; ++e) {
        f32x4 sa = {0.f, 0.f, 0.f, 0.f}, sb = {0.f, 0.f, 0.f, 0.f};
        sa = mfma16(ka0, qf0[e], sa); sa = mfma16(ka1, qf1[e], sa);
        sb = mfma16(kb0, qf0[e], sb); sb = mfma16(kb1, qf1[e], sb);
        softmax_step(sa, sb, m_run[e], l_run[e], O[e], pf[e]);
      }
      const int r1 = 32 * s + 4 * g + q4, r2 = r1 + 16;
#pragma unroll
      for (int dt = 0; dt < 4; ++dt) {
        const s16x4 lo = trread(lds + L_MV + r1 * 128 + 32 * (dt ^ ((r1 >> 1) & 3)) + 8 * p4);
        const s16x4 hi = trread(lds + L_MV + r2 * 128 + 32 * (dt ^ ((r2 >> 1) & 3)) + 8 * p4);
        const bf16x8 vf = cat4(lo, hi);
        O[0][dt] = mfma16(vf, pf[0], O[0][dt]);
        O[1][dt] = mfma16(vf, pf[1], O[1][dt]);
      }
    }
#pragma unroll
    for (int e = 0; e < 2; ++e) attn_finish(Z + (size_t)qtok[e] * NIN + C_GM + head * 64 + 4 * g, l_run[e], O[e]);
  }
}

DI void phase_combine(const Params& p, int layer, int vb, int vg, int tid) {
  bf16_t* Z = (bf16_t*)(p.ws + OFF_Z);
  const int lane = tid & 63, wid = tid >> 6;
  const float* ow = p.hg_onorm_w + layer * 128 + ((8 * lane) & 127);
  float wv[8];
#pragma unroll
  for (int j = 0; j < 8; ++j) wv[j] = ow[j];
  for (int it = vb; it < T_TOK / 4; it += vg) {
    const int tok = it * 4 + wid;
    bf16_t* zr = Z + (size_t)tok * NIN;
    u32x4 a = __builtin_nontemporal_load((const u32x4*)(zr + C_FF + 8 * lane)), b = __builtin_nontemporal_load((const u32x4*)(zr + C_FB + 8 * lane)), gt = __builtin_nontemporal_load((const u32x4*)(zr + C_GH + 8 * lane));
    float o[8]; float s = 0.f;
#pragma unroll
    for (int j = 0; j < 4; ++j) { o[2 * j] = bflo(a[j]) + bflo(b[j]); o[2 * j + 1] = bfhi(a[j]) + bfhi(b[j]); }
#pragma unroll
    for (int j = 0; j < 8; ++j) s += o[j] * o[j];
    s += __shfl_xor(s, 1); s += __shfl_xor(s, 2); s += __shfl_xor(s, 4); s += __shfl_xor(s, 8);
    const float rstd = rsqrtf(s * (1.f / 128.f) + EPS);
    float res[8];
#pragma unroll
    for (int j = 0; j < 4; ++j) {
      res[2 * j] = o[2 * j] * rstd * wv[2 * j] * bflo(gt[j]);
      res[2 * j + 1] = o[2 * j + 1] * rstd * wv[2 * j + 1] * bfhi(gt[j]);
    }
    u32x4 ov = {pk2(res[0], res[1]), pk2(res[2], res[3]), pk2(res[4], res[5]), pk2(res[6], res[7])};
    *(u32x4*)(zr + C_GH + 8 * lane) = ov;
  }
}


#define XB_TMO      128
#define XB_XCNT(j)  (256  + 64 * (j))
#define XB_XSUB(j)  (1280 + 64 * (j))
#define XB_XGEN(j)  (2304 + 64 * (j))
#define XB_TOP      3328
#define XB_TOPGEN   3392
#define XCD_BAR_WORDS 3456
#define XB_SPIN_CAP (1u << 20)
DI unsigned xb_ld(unsigned* p) { return __hip_atomic_load(p, __ATOMIC_RELAXED, __HIP_MEMORY_SCOPE_AGENT); }
DI unsigned xb_add(unsigned* p, unsigned v) { return __hip_atomic_fetch_add(p, v, __ATOMIC_RELAXED, __HIP_MEMORY_SCOPE_AGENT); }
DI unsigned xb_xcc_id() { return (unsigned)__builtin_amdgcn_s_getreg((3 << 11) | 20) & 0xFu; }
#define XB_SPIN(cond, bar) do { unsigned _sp = 0; while (cond) { __builtin_amdgcn_s_sleep(1); \
    if ((++_sp & 255u) == 0u) { if (xb_ld(&(bar)[XB_TMO])) break; if (_sp > XB_SPIN_CAP) { atomicAdd(&(bar)[XB_TMO], 1u); break; } } } } while (0)
struct XcdBarrier { unsigned* bar; unsigned x; unsigned nloc, nx; };
DI void xcd_barrier_complete(unsigned* bar, unsigned x, unsigned& nloc, unsigned& nx) {
  const unsigned G = gridDim.x * gridDim.y * gridDim.z;
  unsigned sum, cnt, mine, sp = 0u;
  for (;;) {
    sum = 0u; cnt = 0u; mine = 0u;
#pragma unroll
    for (unsigned j = 0; j < 16; ++j) { const unsigned c = xb_ld(&bar[XB_XCNT(j)]); sum += c; cnt += (c > 0u) ? 1u : 0u; mine = (j == x) ? c : mine; }
    if (sum == G) break;
    __builtin_amdgcn_s_sleep(1);
    if ((++sp & 255u) == 0u) { if (xb_ld(&bar[XB_TMO])) break; if (sp > XB_SPIN_CAP) { atomicAdd(&bar[XB_TMO], 1u); break; } }
  }
  nloc = mine > 0u ? mine : 1u; nx = cnt > 0u ? cnt : 1u;
}
DI void xcd_barrier(unsigned* bar_) {
  asm volatile("s_waitcnt vmcnt(0)" ::: "memory");
  __syncthreads();
  if (threadIdx.x == 0) {
    unsigned* bar = bar_;
    __builtin_amdgcn_s_waitcnt(0);
    const unsigned bx = xb_xcc_id();
    unsigned nloc, nx; xcd_barrier_complete(bar, bx, nloc, nx);
    const unsigned old = xb_add(&bar[XB_XSUB(bx)], 1u);
    const unsigned gen = old / nloc;
    if (old + 1u == (gen + 1u) * nloc) {
      __builtin_amdgcn_fence(__ATOMIC_RELEASE, "agent");
      asm volatile("s_waitcnt vmcnt(0)" ::: "memory");
      const unsigned og = xb_add(&bar[XB_TOP], 1u);
      const unsigned tg = og / nx;
      if (og + 1u == (tg + 1u) * nx) xb_add(&bar[XB_TOPGEN], 1u);
      else XB_SPIN(xb_ld(&bar[XB_TOPGEN]) == tg, bar);
      __builtin_amdgcn_fence(__ATOMIC_ACQUIRE, "agent");
      xb_add(&bar[XB_XGEN(bx)], 1u);
      asm volatile("s_waitcnt vmcnt(0)" ::: "memory");
    } else {
      XB_SPIN(xb_ld(&bar[XB_XGEN(bx)]) == gen, bar);
      __builtin_amdgcn_fence(__ATOMIC_ACQUIRE, "agent");
      asm volatile("s_waitcnt vmcnt(0)" ::: "memory");
    }
  }
  __syncthreads();
}

__global__ void __launch_bounds__(512) fwd_megakernel(Params p) {
  cg::grid_group grid = cg::this_grid();
  extern __shared__ __attribute__((aligned(16))) unsigned char lds[];

  const int wave_u = __builtin_amdgcn_readfirstlane((int)(threadIdx.x >> 6));
#define OPAQUE_TID() ({ int l_; asm volatile("v_mbcnt_lo_u32_b32 %0, -1, 0\n\tv_mbcnt_hi_u32_b32 %0, -1, %0" : "=v"(l_)); wave_u * 64 + l_; })
#define VSPLIT() const int t512 = OPAQUE_TID(); const int tid = t512 & 255, hb = __builtin_amdgcn_readfirstlane(t512 >> 8); const int vb = blockIdx.x * 2 + hb, vg = gridDim.x * 2; unsigned char* ldh = lds + hb * 65536; (void)vb; (void)vg; (void)ldh; (void)tid;
  if (threadIdx.x == 0) (void)xb_add(&((unsigned*)(p.ws + OFF_BAR))[XB_XCNT(xb_xcc_id())], 1u);
  { VSPLIT(); phase_prep(p, ldh, vb, vg, tid); }
  grid.sync();
  for (int layer = 0; layer < 4; ++layer) {
    phase_inproj(p, layer, lds, OPAQUE_TID());
    xcd_barrier((unsigned*)(p.ws + OFF_BAR));
    {
      VSPLIT();
      float* XSS = (float*)(p.ws + OFF_XSS);
#pragma unroll
      for (int k = 0; k < 8; ++k) { const int i = vb * 256 + tid + k * vg * 256; if (i < T_TOK) XSS[i] = 0.f; }
      constexpr int N_S1 = N_UNITS, N_AT = 6144;
      for (int it = vb; it < N_S1 + N_AT; it += vg) {
        if (it < N_S1) scan_unit<false>(p, layer, it, ldh, tid);
        else {
          int ai = it - N_S1;
          if (gridDim.x == 256) {
            const int k = ai >> 9, x = (vb >> 1) & 7, j = (vb >> 4) * 2 + (vb & 1);
            ai = (((k * 8 + x) * 4 + (j >> 4)) << 4) + (j & 15);
          }
          __syncthreads(); attn_dilated(p, ai * 4 + (tid >> 6), ldh + (tid >> 6) * 4608, tid & 63);
        }
      }
    }
    xcd_barrier((unsigned*)(p.ws + OFF_BAR));
    {
      VSPLIT();
      phase_carry(p, vb, vg, tid);
      constexpr int N_MEM = (T_TOK / 256) * 4;
      for (int it = vb; it < N_MEM; it += vg) attn_mem_item(p, layer, it, ldh, tid);
    }
    xcd_barrier((unsigned*)(p.ws + OFF_BAR));
    {
      VSPLIT();
      for (int it = vb; it < N_UNITS; it += vg) scan_unit<true>(p, layer, it, ldh, tid);
    }
    xcd_barrier((unsigned*)(p.ws + OFF_BAR));
    { VSPLIT(); phase_combine(p, layer, vb, vg, tid); }
    xcd_barrier((unsigned*)(p.ws + OFF_BAR));
    phase_outproj(p, layer, lds, OPAQUE_TID());
    if (layer < 3) xcd_barrier((unsigned*)(p.ws + OFF_BAR));
  }
}

extern "C" void kernel_launch(void* const* d_in, const int* in_sizes, int n_in, void* d_out, int out_size, void* d_ws,
                              size_t ws_size, hipStream_t stream) {
  if (ws_size < WS_NEED) { fprintf(stderr, "workspace too small: %zu < %zu\n", ws_size, (size_t)WS_NEED); return; }
  constexpr int kDynLds = 131072;
  static int grid_blocks = 0;
  if (!grid_blocks) {
    int dev = 0, cus = 0, per_cu = 0;
    (void)hipGetDevice(&dev);
    (void)hipDeviceGetAttribute(&cus, hipDeviceAttributeMultiprocessorCount, dev);
    if (hipFuncSetAttribute((const void*)fwd_megakernel, hipFuncAttributeMaxDynamicSharedMemorySize, kDynLds) != hipSuccess) {
      fprintf(stderr, "hipFuncSetAttribute failed\n"); grid_blocks = -1; return;
    }
    (void)hipOccupancyMaxActiveBlocksPerMultiprocessor(&per_cu, fwd_megakernel, 512, kDynLds);
    if (per_cu < 1) fprintf(stderr, "occupancy query reports %d blocks per CU\n", per_cu);
    grid_blocks = cus;
  }
  if (grid_blocks < 0) return;
  Params p{};
  p.x_prompt = (const float*)d_in[0]; p.x_sample = (const float*)d_in[1]; p.mem_prompt = (const float*)d_in[2]; p.mem_sample = (const float*)d_in[3];
  p.norm_w = (const float*)d_in[4]; p.w_in = (const float*)d_in[5]; p.lb_fwd = (const float*)d_in[6]; p.lb_bwd = (const float*)d_in[7];
  p.hg_onorm_w = (const float*)d_in[8]; p.aq_w = (const float*)d_in[9]; p.ak_w = (const float*)d_in[10]; p.mem_norm_w = (const float*)d_in[11];
  p.mem_wkv = (const float*)d_in[12]; p.mq_w = (const float*)d_in[13]; p.mk_w = (const float*)d_in[14]; p.w_out = (const float*)d_in[15];
  p.out = (float*)d_out; p.ws = (unsigned char*)d_ws;
  (void)hipMemsetAsync((unsigned char*)d_ws + OFF_BAR, 0, SZ_BAR, stream);
  void* args[] = {&p};
  hipError_t e = hipLaunchCooperativeKernel((void*)fwd_megakernel, dim3(grid_blocks), dim3(512), args, kDynLds, stream);
  if (e != hipSuccess) fprintf(stderr, "cooperative launch failed: %s (grid %d)\n", hipGetErrorString(e), grid_blocks);
}
```
